# Optimizing an MI355X kernel written in HIP

```python
import jax, jax.numpy as jnp
from jax import lax
import numpy as np

D_MODEL = 2048
BATCH = 8
SEQ = 2048
DEPTH = 1

CHUNK = 64
N_MEM = 256
MIX_WIDTH = D_MODEL
W_A = MIX_WIDTH // 2
G_A = 8
GA_DIM = W_A // G_A
SGU_BLOCK = 128
W_B = MIX_WIDTH - W_A
H_B = 8
DH_B = W_B // H_B
Q_BLOCK = 128
X_HEADS = 4
X_DH = D_MODEL // X_HEADS
D_FF = 5632
EPS = 1e-6

kernel_name = "hybrid_sgu_stickbreak_macaron_block"


def rmsnorm(x, g):
    xf = x.astype(jnp.float32)
    y = xf * lax.rsqrt(jnp.mean(xf * xf, axis=-1, keepdims=True) + EPS)
    return (y * g.astype(jnp.float32)).astype(x.dtype)


def layernorm(x, g, b):
    xf = x.astype(jnp.float32)
    mu = jnp.mean(xf, axis=-1, keepdims=True)
    var = jnp.mean(jnp.square(xf - mu), axis=-1, keepdims=True)
    y = (xf - mu) * lax.rsqrt(var + EPS)
    return (y * g.astype(jnp.float32) + b.astype(jnp.float32)).astype(x.dtype)


def swiglu(x, w_in, w_out):
    gate, up = jnp.split(x @ w_in, 2, axis=-1)
    return (jax.nn.silu(gate) * up) @ w_out


def spatial_gating_unit(za, ln_g, ln_b, w_s, b_s):
    bsz, seq, _ = za.shape
    u, v = jnp.split(za, 2, axis=-1)
    v = layernorm(v.reshape(bsz, seq, G_A, GA_DIM),
                  ln_g.reshape(G_A, GA_DIM), ln_b.reshape(G_A, GA_DIM))
    v = v.reshape(bsz, seq // SGU_BLOCK, SGU_BLOCK, G_A, GA_DIM)
    cidx = jnp.arange(SGU_BLOCK) // CHUNK
    mask = cidx[None, :] <= cidx[:, None]
    w = jnp.where(mask[None], w_s, jnp.zeros((), w_s.dtype))
    mixed = jnp.einsum('gts,bnsgc->bntgc', w, v) + b_s.T[:, :, None]
    return u * mixed.reshape(bsz, seq, W_A)


def stick_breaking_attention(q, k, v):
    seq = q.shape[1]
    q = q * (DH_B ** -0.5)
    outs = []
    for i in range(seq // Q_BLOCK):
        end = (i + 1) * Q_BLOCK
        q_blk = q[:, i * Q_BLOCK:end]
        k_pre, v_pre = k[:, :end], v[:, :end]
        z = jnp.einsum('bqhd,bkhd->bhqk', q_blk, k_pre).astype(jnp.float32)
        t_pos = i * Q_BLOCK + jnp.arange(Q_BLOCK)
        s_pos = jnp.arange(end)
        causal = s_pos[None, :] < t_pos[:, None]
        log_beta = jax.nn.log_sigmoid(z)
        log_1m = jnp.where(causal, jax.nn.log_sigmoid(-z), 0.0)
        rest = lax.cumsum(log_1m, axis=3, reverse=True) - log_1m
        a = jnp.where(causal, jnp.exp(log_beta + rest), 0.0)
        outs.append(jnp.einsum('bhqk,bkhd->bqhd', a.astype(v.dtype), v_pre))
    return jnp.concatenate(outs, axis=1)


def memory_cross_attention(xn, memn, w_cq, w_ckv, w_co):
    bsz, seq, _ = xn.shape
    q = (xn @ w_cq).reshape(bsz, seq, X_HEADS, X_DH) * (X_DH ** -0.5)
    k, v = jnp.split(memn @ w_ckv, 2, axis=-1)
    k = k.reshape(bsz, N_MEM, X_HEADS, X_DH)
    v = v.reshape(bsz, N_MEM, X_HEADS, X_DH)
    s = jnp.einsum('bshd,bmhd->bhsm', q, k).astype(jnp.float32)
    p = jax.nn.softmax(s, axis=-1).astype(v.dtype)
    o = jnp.einsum('bhsm,bmhd->bshd', p, v).reshape(bsz, seq, D_MODEL)
    return o @ w_co


def setup_inputs(seed: int = 0) -> dict:
    key = jax.random.key(seed)
    ks = jax.random.split(key, 32)
    f32 = jnp.float32

    def w(k, shape, fan_in):
        return jax.random.normal(k, shape, f32) * (fan_in ** -0.5)

    def gain(k, shape):
        return 1.0 + 0.05 * jax.random.normal(k, shape, f32)

    L = DEPTH
    return {
        "x": jax.random.normal(ks[0], (BATCH, SEQ, D_MODEL), f32),
        "mem": jax.random.normal(ks[1], (BATCH, N_MEM, D_MODEL), f32),
        "ffn1_norm": gain(ks[2], (L, D_MODEL)),
        "ffn1_w_in": w(ks[3], (L, D_MODEL, 2 * D_FF), D_MODEL),
        "ffn1_w_out": w(ks[4], (L, D_FF, D_MODEL), D_FF),
        "mix_norm": gain(ks[5], (L, D_MODEL)),
        "w_mix_in": w(ks[6], (L, D_MODEL, 2 * W_A + 3 * W_B), D_MODEL),
        "ln_v_gain": gain(ks[7], (L, W_A)),
        "ln_v_bias": 0.02 * jax.random.normal(ks[8], (L, W_A), f32),
        "spatial_w": w(ks[9], (L, G_A, SGU_BLOCK, SGU_BLOCK), SGU_BLOCK),
        "spatial_b": 1.0 + 0.1 * jax.random.normal(ks[10], (L, G_A, SGU_BLOCK), f32),
        "gnorm_a": gain(ks[11], (L, W_A)),
        "gnorm_b": gain(ks[12], (L, W_B)),
        "w_mix_out": w(ks[13], (L, MIX_WIDTH, D_MODEL), MIX_WIDTH),
        "cross_norm": gain(ks[14], (L, D_MODEL)),
        "mem_norm": gain(ks[15], (L, D_MODEL)),
        "w_cq": w(ks[16], (L, D_MODEL, D_MODEL), D_MODEL),
        "w_ckv": w(ks[17], (L, D_MODEL, 2 * D_MODEL), D_MODEL),
        "w_co": w(ks[18], (L, D_MODEL, D_MODEL), D_MODEL),
        "ffn2_norm": gain(ks[19], (L, D_MODEL)),
        "ffn2_w_in": w(ks[20], (L, D_MODEL, 2 * D_FF), D_MODEL),
        "ffn2_w_out": w(ks[21], (L, D_FF, D_MODEL), D_FF),
        "final_norm": gain(ks[22], (D_MODEL,)),
    }


def reference(x, mem, ffn1_norm, ffn1_w_in, ffn1_w_out, mix_norm, w_mix_in,
              ln_v_gain, ln_v_bias, spatial_w, spatial_b, gnorm_a, gnorm_b,
              w_mix_out, cross_norm, mem_norm, w_cq, w_ckv, w_co,
              ffn2_norm, ffn2_w_in, ffn2_w_out, final_norm):
    bsz, seq, _ = x.shape
    h = x
    for l in range(DEPTH):
        h = h + 0.5 * swiglu(rmsnorm(h, ffn1_norm[l]), ffn1_w_in[l], ffn1_w_out[l])

        z = rmsnorm(h, mix_norm[l]) @ w_mix_in[l]
        za = jax.nn.gelu(z[..., :2 * W_A])
        q, k, v = jnp.split(z[..., 2 * W_A:], 3, axis=-1)
        y_a = spatial_gating_unit(za, ln_v_gain[l], ln_v_bias[l], spatial_w[l], spatial_b[l])
        y_b = stick_breaking_attention(q.reshape(bsz, seq, H_B, DH_B),
                                       k.reshape(bsz, seq, H_B, DH_B),
                                       v.reshape(bsz, seq, H_B, DH_B)).reshape(bsz, seq, W_B)
        y = jnp.concatenate([rmsnorm(y_a, gnorm_a[l]), rmsnorm(y_b, gnorm_b[l])], axis=-1)
        h = h + y @ w_mix_out[l]

        h = h + memory_cross_attention(rmsnorm(h, cross_norm[l]), rmsnorm(mem, mem_norm[l]),
                                       w_cq[l], w_ckv[l], w_co[l])

        h = h + 0.5 * swiglu(rmsnorm(h, ffn2_norm[l]), ffn2_w_in[l], ffn2_w_out[l])
    return rmsnorm(h, final_norm)
```

```cpp
#include <hip/hip_runtime.h>
#include <hip/hip_cooperative_groups.h>
#include <cstdio>
namespace cg = cooperative_groups;

#define LAS __attribute__((address_space(3)))
typedef unsigned short bf16_t;
typedef short bf16x8 __attribute__((ext_vector_type(8)));
typedef float f32x4 __attribute__((ext_vector_type(4)));
typedef float f32x2 __attribute__((ext_vector_type(2)));
typedef unsigned u32x4 __attribute__((ext_vector_type(4)));
typedef unsigned u32x2 __attribute__((ext_vector_type(2)));

constexpr int MTOK = 16384, DM = 2048, DFF = 5632, SEQ = 2048, NB = 8, NMEM = 256, MEMROWS = NB * NMEM;
constexpr float EPS = 1e-6f;
constexpr size_t MiB = 1024 * 1024;
constexpr size_t WS_WT_IN1 = 0;
constexpr size_t WS_WT_OUT1 = WS_WT_IN1 + 44 * MiB;
constexpr size_t WS_WT_MIXIN = WS_WT_OUT1 + 22 * MiB;
constexpr size_t WS_WT_MIXOUT = WS_WT_MIXIN + 20 * MiB;
constexpr size_t WS_WT_CQ = WS_WT_MIXOUT + 8 * MiB;
constexpr size_t WS_WT_CKV = WS_WT_CQ + 8 * MiB;
constexpr size_t WS_WT_CO = WS_WT_CKV + 16 * MiB;
constexpr size_t WS_WT_IN2 = WS_WT_CO + 8 * MiB;
constexpr size_t WS_WT_OUT2 = WS_WT_IN2 + 44 * MiB;
constexpr size_t WS_XN = WS_WT_OUT2 + 22 * MiB;
constexpr size_t WS_HB = WS_XN + 64 * MiB;
constexpr size_t WS_ACT = WS_HB + 64 * MiB;
constexpr size_t WS_ZA = WS_ACT;
constexpr size_t WS_QB = WS_ZA + 64 * MiB;
constexpr size_t WS_KB = WS_QB + 32 * MiB;
constexpr size_t WS_VT = WS_KB + 32 * MiB;
constexpr size_t WS_MT = WS_ACT;
constexpr size_t WS_VWT = WS_MT + 32 * MiB;
constexpr size_t WS_P = WS_VWT + 32 * MiB;
constexpr size_t WS_MEMN = WS_ACT + 176 * MiB;
constexpr size_t WS_KV = WS_MEMN + 8 * MiB;
constexpr size_t WS_VTX = WS_KV + 8 * MiB;
constexpr size_t WS_SS = WS_VTX + 8 * MiB;
constexpr size_t WS_BAR = WS_SS + 512 * 1024;
constexpr size_t WS_END = WS_SS + 1 * MiB;

struct Params {
    const float* x; const float* mem; const float* ffn1_norm; const float* ffn1_w_in; const float* ffn1_w_out; const float* mix_norm; const float* w_mix_in;
    const float* ln_v_gain; const float* ln_v_bias; const float* spatial_w; const float* spatial_b; const float* gnorm_a; const float* gnorm_b; const float* w_mix_out;
    const float* cross_norm; const float* mem_norm; const float* w_cq; const float* w_ckv; const float* w_co; const float* ffn2_norm; const float* ffn2_w_in;
    const float* ffn2_w_out; const float* final_norm;
    float* out; unsigned char* ws; int ph_lo, ph_hi;
};

typedef __bf16 bf16x2_t __attribute__((ext_vector_type(2)));
typedef float f32x16 __attribute__((ext_vector_type(16)));
__device__ __forceinline__ unsigned pk_bf16(float lo, float hi) { f32x2 v = {lo, hi}; bf16x2_t r = __builtin_convertvector(v, bf16x2_t); return __builtin_bit_cast(unsigned, r); }
#define MFMA32(a, b, c) __builtin_amdgcn_mfma_f32_32x32x16_bf16((a), (b), (c), 0, 0, 0)
__device__ __forceinline__ float bf_lo(unsigned u) { return __uint_as_float(u << 16); }
__device__ __forceinline__ float bf_hi(unsigned u) { return __uint_as_float(u & 0xffff0000u); }
__device__ __forceinline__ float wave_sum(float v) {
#pragma unroll
    for (int o = 1; o < 64; o <<= 1) v += __shfl_xor(v, o);
    return v;
}
__device__ __forceinline__ float wave_max(float v) {
#pragma unroll
    for (int o = 1; o < 64; o <<= 1) v = fmaxf(v, __shfl_xor(v, o));
    return v;
}
__device__ __forceinline__ float gelu_tanh(float x) { const float u2 = -2.302208198f * (x + 0.044715f * x * x * x); return x * __builtin_amdgcn_rcpf(1.f + __builtin_amdgcn_exp2f(u2)); }
__device__ __forceinline__ float silu(float g) { return g * __builtin_amdgcn_rcpf(1.f + __builtin_amdgcn_exp2f(-1.4426950408889634f * g)); }
__device__ __forceinline__ float rstd_of(float ss) { return rsqrtf(ss * (1.f / DM) + EPS); }
__device__ __forceinline__ int opaque_tid() { int t = threadIdx.x; asm volatile("" : "+v"(t)); return t; }
__device__ __forceinline__ const char* uni_ptr(const char* p) {
    const unsigned long long v = (unsigned long long)p;
    const unsigned lo = __builtin_amdgcn_readfirstlane((unsigned)v), hi = __builtin_amdgcn_readfirstlane((unsigned)(v >> 32));
    return (const char*)(((unsigned long long)hi << 32) | lo); }
#define LDS_WAIT() asm volatile("s_waitcnt lgkmcnt(0)" ::: "memory")

namespace pg8 {
constexpr int BM = 256, BK = 64, HALF = 128, HTB = HALF * BK * 2, STAGE_BYTES = 8 * HTB, NXCD = 8, WGM = 8;
__device__ __forceinline__ int lds_byte(int r, int c) { const int st = (r >> 4) * 2 + (c >> 5), rr = r & 15, cc = c & 31, ob = rr * 64 + cc * 2; return st * 1024 + (ob ^ (((ob >> 9) & 1) << 5)); }
__device__ __forceinline__ void stage_rc(int b, int& R, int& C) { const int st = b / 1024, sb = b % 1024, swz = sb ^ (((sb >> 9) & 1) << 5); R = (st >> 1) * 16 + swz / 64; C = (st & 1) * 32 + (swz % 64) / 2; }
__device__ __forceinline__ int perm32(int rho) { const int n = rho >> 4, i = rho & 15; return 8 * (i >> 2) + 4 * n + (i & 3); }

struct Unit { const char* A; const char* B; int pm, pn, sub, round, aux; };
struct SubG { const bf16_t* A; const bf16_t* B; int nM, nN; };

template <int NS, size_t KSA_ = 128, size_t KSB_ = 128> struct MultiOrder {
    static constexpr size_t KSA = KSA_, KSB = KSB_;
    SubG s[NS]; int G, c; size_t lda, ldb;
    __device__ __forceinline__ bool next(int i, Unit& u) const {
        long L = (long)i * G + c;
#pragma unroll
        for (int j = 0; j < NS; ++j) {
            const int nM = s[j].nM, nN = s[j].nN, nwg = nM * nN;
            if (L < nwg) {
                int wgid = (int)L; { const int q = nwg / NXCD, r = nwg % NXCD, xcd = wgid % NXCD, off = wgid / NXCD; wgid = (xcd < r ? xcd * (q + 1) : r * (q + 1) + (xcd - r) * q) + off; }
                const int nig = WGM * nN, gid = wgid / nig, fm = gid * WGM, gsz = (nM - fm) < WGM ? (nM - fm) : WGM;
                u.pm = fm + ((wgid % nig) % gsz); u.pn = (wgid % nig) / gsz; u.sub = j; u.round = i; u.aux = 0;
                u.A = (const char*)s[j].A + (size_t)u.pm * 256 * lda * 2; u.B = (const char*)s[j].B + (size_t)u.pn * 256 * ldb * 2;
                return true;
            }
            L -= nwg;
        }
        return false;
    }
};

#ifndef PG8_SP2
#define PG8_SP2 true
#endif
#ifndef PG8_ALIGN
#define PG8_ALIGN true
#endif
template <class Epi, class Sched, bool ALIGN_EPI = PG8_ALIGN, bool SP2 = PG8_SP2>
__device__ __forceinline__ void gemm_phase(LAS unsigned char* lds, const int K, const Sched S, const Epi E) {
    const int tid = opaque_tid(), wid = __builtin_amdgcn_readfirstlane(tid >> 6), lane = tid & 63, wr = wid >> 2, wc = wid & 3, fr = lane & 15, fq = lane >> 4;
    const int nt = K / BK;
    const int lda = (int)S.lda, ldb = (int)S.ldb;
    unsigned voffA[2], voffB[2];
#pragma unroll
    for (int i = 0; i < 2; ++i) { int R, C; stage_rc(tid * 16 + i * 8192, R, C); const int Rb = Epi::PERM ? ((R & ~31) + perm32(R & 31)) : R;
        voffA[i] = (unsigned)(R * lda + C) * 2u; voffB[i] = (unsigned)(Rb * ldb + C) * 2u; }
    constexpr size_t kstepA = Sched::KSA, kstepB = Sched::KSB;
    const size_t hstepA = (size_t)HALF * lda * 2, hstepB = (size_t)HALF * ldb * 2;
    const unsigned ldsw = (unsigned)wid * 1024u;
    const int aoff = lds_byte(wr * 64 + fr, fq * 8), boff = lds_byte(wc * 32 + fr, fq * 8);
#define PG8_SA(b, h) (((b) * 2 + (h)) * HTB)
#define PG8_SB(b, h) ((4 + (b) * 2 + (h)) * HTB)
#define PG8_STAGE(bufoff, gbase, voff) do { _Pragma("unroll") for (int _i = 0; _i < 2; ++_i) \
        __builtin_amdgcn_global_load_lds((const unsigned*)((const char*)(gbase) + (voff)[_i]), (LAS unsigned*)(lds + (bufoff) + ldsw + _i * 8192), 16, 0, 0); } while (0)
#define PG8_LDA(dst, b, h) do { _Pragma("unroll") for (int m = 0; m < 4; ++m) _Pragma("unroll") for (int k = 0; k < 2; ++k) dst[m][k] = *(const LAS bf16x8*)(lds + PG8_SA(b, h) + aoff + m * 2048 + k * 1024); } while (0)
#define PG8_LDB(dst, b, h) do { _Pragma("unroll") for (int n = 0; n < 2; ++n) _Pragma("unroll") for (int k = 0; k < 2; ++k) dst[n][k] = *(const LAS bf16x8*)(lds + PG8_SB(b, h) + boff + n * 2048 + k * 1024); } while (0)
#define PG8_MMA(ai, bj, At, Bt) do { __builtin_amdgcn_s_setprio(1); _Pragma("unroll") for (int m = 0; m < 4; ++m) _Pragma("unroll") for (int n = 0; n < 2; ++n) _Pragma("unroll") for (int k = 0; k < 2; ++k) \
        acc[ai][bj][m][n] = __builtin_amdgcn_mfma_f32_16x16x32_bf16(Bt[n][k], At[m][k], acc[ai][bj][m][n], 0, 0, 0); __builtin_amdgcn_s_setprio(0); } while (0)
#define PG8_MMA2(ai, bj, At, Bt, ai2, bj2, At2, Bt2) do { __builtin_amdgcn_s_setprio(1); _Pragma("unroll") for (int m = 0; m < 4; ++m) _Pragma("unroll") for (int n = 0; n < 2; ++n) _Pragma("unroll") for (int k = 0; k < 2; ++k) \
        acc[ai][bj][m][n] = __builtin_amdgcn_mfma_f32_16x16x32_bf16(Bt[n][k], At[m][k], acc[ai][bj][m][n], 0, 0, 0); \
        _Pragma("unroll") for (int m = 0; m < 4; ++m) _Pragma("unroll") for (int n = 0; n < 2; ++n) _Pragma("unroll") for (int k = 0; k < 2; ++k) \
        acc[ai2][bj2][m][n] = __builtin_amdgcn_mfma_f32_16x16x32_bf16(Bt2[n][k], At2[m][k], acc[ai2][bj2][m][n], 0, 0, 0); __builtin_amdgcn_s_setprio(0); } while (0)
#define PG8_WAIT_V(n) asm volatile("s_waitcnt vmcnt(" #n ")" ::: "memory")
#define PG8_WAIT_L(n) asm volatile("s_waitcnt lgkmcnt(" #n ")" ::: "memory")
#define PG8_BAR __builtin_amdgcn_s_barrier()
#define PG8_SCHED __builtin_amdgcn_sched_barrier(0)
    Unit cur, nxt; int ui = 0;
    if (!S.next(0, cur)) return;
    f32x4 acc[2][2][4][2];
#pragma unroll
    for (int a = 0; a < 2; ++a)
#pragma unroll
        for (int b = 0; b < 2; ++b)
#pragma unroll
            for (int m = 0; m < 4; ++m)
#pragma unroll
                for (int n = 0; n < 2; ++n) acc[a][b][m][n] = (f32x4){0.f, 0.f, 0.f, 0.f};
    bf16x8 At[4][2], B0[2][2], B1[2][2];
    const char* cA = uni_ptr(cur.A); const char* cB = uni_ptr(cur.B);
    if constexpr (SP2) {
        PG8_STAGE(PG8_SB(0, 0), cB, voffB); PG8_STAGE(PG8_SB(0, 1), cB + hstepB, voffB); PG8_STAGE(PG8_SA(0, 0), cA, voffA); PG8_STAGE(PG8_SA(0, 1), cA + hstepA, voffA);
        if (wr == 1) PG8_BAR;
        PG8_WAIT_V(2); PG8_BAR;
        PG8_STAGE(PG8_SB(1, 0), cB + kstepB, voffB); PG8_STAGE(PG8_SA(1, 0), cA + kstepA, voffA); PG8_STAGE(PG8_SB(1, 1), cB + hstepB + kstepB, voffB);
        PG8_WAIT_V(6); PG8_BAR;
    } else {
        PG8_STAGE(PG8_SB(0, 0), cB, voffB); PG8_STAGE(PG8_SA(0, 0), cA, voffA); PG8_STAGE(PG8_SB(0, 1), cB + hstepB, voffB); PG8_STAGE(PG8_SA(0, 1), cA + hstepA, voffA);
        if (wr == 1) PG8_BAR;
        PG8_WAIT_V(4); PG8_BAR;
        PG8_STAGE(PG8_SB(1, 0), cB + kstepB, voffB); PG8_STAGE(PG8_SA(1, 0), cA + kstepA, voffA); PG8_STAGE(PG8_SB(1, 1), cB + hstepB + kstepB, voffB);
        PG8_WAIT_V(6); PG8_BAR;
    }
    for (;;) {
        const bool has_next = S.next(ui + 1, nxt);
        const char* nA = uni_ptr(has_next ? nxt.A : cA); const char* nB = uni_ptr(has_next ? nxt.B : cB);
        for (int t = 0; t < nt; t += 2) {
            const bool last = (t == nt - 2);
            const char* a1 = cA + (size_t)(t + 1) * kstepA;
            const char* a2 = last ? nA : cA + (size_t)(t + 2) * kstepA; const char* b2 = last ? nB : cB + (size_t)(t + 2) * kstepB;
            const char* a3 = a2 + kstepA; const char* b3 = b2 + kstepB;
            if constexpr (Epi::MIDK > 0) { if (t == Epi::MIDK) E.mid(acc, cur, wr, fr); }
            if constexpr (SP2) {
            PG8_LDB(B0, 0, 0); PG8_LDB(B1, 0, 1); PG8_SCHED; PG8_LDA(At, 0, 0); PG8_STAGE(PG8_SA(1, 1), a1 + hstepA, voffA);
            PG8_WAIT_V(8); PG8_WAIT_L(0); PG8_BAR; PG8_MMA2(0, 0, At, B0, 0, 1, At, B1); PG8_BAR; PG8_SCHED;
            PG8_LDA(At, 0, 1); PG8_STAGE(PG8_SB(0, 0), b2, voffB); PG8_STAGE(PG8_SB(0, 1), b2 + hstepB, voffB); PG8_STAGE(PG8_SA(0, 0), a2, voffA);
            PG8_WAIT_V(8); PG8_WAIT_L(0); PG8_BAR; PG8_MMA2(1, 0, At, B0, 1, 1, At, B1); PG8_BAR; PG8_SCHED;
            PG8_LDB(B0, 1, 0); PG8_LDB(B1, 1, 1); PG8_SCHED; PG8_LDA(At, 1, 0); PG8_STAGE(PG8_SA(0, 1), a2 + hstepA, voffA);
            PG8_WAIT_V(8); PG8_WAIT_L(0); PG8_BAR; PG8_MMA2(0, 0, At, B0, 0, 1, At, B1); PG8_BAR; PG8_SCHED;
            PG8_LDA(At, 1, 1); PG8_STAGE(PG8_SB(1, 0), b3, voffB); PG8_STAGE(PG8_SB(1, 1), b3 + hstepB, voffB); PG8_STAGE(PG8_SA(1, 0), a3, voffA);
            PG8_WAIT_V(8); PG8_WAIT_L(0); PG8_BAR; PG8_MMA2(1, 0, At, B0, 1, 1, At, B1); PG8_BAR; PG8_SCHED;
            } else {
            PG8_LDB(B0, 0, 0); PG8_SCHED; PG8_LDA(At, 0, 0); PG8_STAGE(PG8_SA(1, 1), a1 + hstepA, voffA);
            PG8_WAIT_L(8); PG8_BAR; PG8_WAIT_L(0); PG8_MMA(0, 0, At, B0); PG8_BAR; PG8_SCHED;
            PG8_LDB(B1, 0, 1); PG8_STAGE(PG8_SB(0, 0), b2, voffB);
            PG8_BAR; PG8_WAIT_L(0); PG8_MMA(0, 1, At, B1); PG8_BAR;
            PG8_LDA(At, 0, 1); PG8_STAGE(PG8_SA(0, 0), a2, voffA);
            PG8_BAR; PG8_WAIT_L(0); PG8_MMA(1, 0, At, B0); PG8_BAR; PG8_SCHED;
            PG8_STAGE(PG8_SB(0, 1), b2 + hstepB, voffB);
            PG8_WAIT_V(6); PG8_BAR; PG8_MMA(1, 1, At, B1); PG8_BAR;
            PG8_LDB(B0, 1, 0); PG8_SCHED; PG8_LDA(At, 1, 0); PG8_STAGE(PG8_SA(0, 1), a2 + hstepA, voffA);
            PG8_WAIT_L(8); PG8_BAR; PG8_WAIT_L(0); PG8_MMA(0, 0, At, B0); PG8_BAR; PG8_SCHED;
            PG8_LDB(B1, 1, 1); PG8_STAGE(PG8_SB(1, 0), b3, voffB);
            PG8_BAR; PG8_WAIT_L(0); PG8_MMA(0, 1, At, B1); PG8_BAR;
            PG8_LDA(At, 1, 1); PG8_STAGE(PG8_SA(1, 0), a3, voffA);
            PG8_BAR; PG8_WAIT_L(0); PG8_MMA(1, 0, At, B0); PG8_BAR; PG8_SCHED;
            PG8_STAGE(PG8_SB(1, 1), b3 + hstepB, voffB);
            PG8_WAIT_V(6); PG8_BAR; PG8_MMA(1, 1, At, B1); PG8_BAR;
                    }
        }
        if constexpr (ALIGN_EPI) { if (wr == 0) PG8_BAR; }
        E(acc, cur, wr, wc, fr, fq);
        if (!has_next) break;
#pragma unroll
        for (int a = 0; a < 2; ++a)
#pragma unroll
            for (int b = 0; b < 2; ++b)
#pragma unroll
                for (int m = 0; m < 4; ++m)
#pragma unroll
                    for (int n = 0; n < 2; ++n) acc[a][b][m][n] = (f32x4){0.f, 0.f, 0.f, 0.f};
        cur = nxt; cA = nA; cB = nB; ++ui;
        if constexpr (ALIGN_EPI) { if (wr == 1) PG8_BAR; }
    }
    PG8_WAIT_V(0);
    if constexpr (!ALIGN_EPI) { if (wr == 0) PG8_BAR; }
    PG8_BAR;
#undef PG8_SA
#undef PG8_SB
#undef PG8_STAGE
#undef PG8_LDA
#undef PG8_LDB
#undef PG8_MMA
#undef PG8_MMA2
#undef PG8_WAIT_V
#undef PG8_WAIT_L
#undef PG8_BAR
#undef PG8_SCHED
}

template <int ACT> __device__ __forceinline__ void store_bf16_tile(const f32x4 (&acc)[2][2][4][2], bf16_t* tile, size_t ld, float scale, const float* rowss, const float* colss, int wr, int wc, int fr, int fq) {
    f32x4 cs[2][2];
#pragma unroll
    for (int bj = 0; bj < 2; ++bj)
#pragma unroll
        for (int n = 0; n < 2; ++n) { cs[bj][n] = (f32x4){scale, scale, scale, scale};
            if (colss) { const f32x4 t = *(const f32x4*)(colss + bj * HALF + wc * 32 + 8 * fq + 4 * n); cs[bj][n] = (f32x4){rstd_of(t.x), rstd_of(t.y), rstd_of(t.z), rstd_of(t.w)} * scale; } }
#pragma unroll
    for (int ai = 0; ai < 2; ++ai)
#pragma unroll
        for (int m = 0; m < 4; ++m) { const int r = ai * HALF + wr * 64 + m * 16 + fr; bf16_t* rowp = tile + (size_t)r * ld + wc * 32 + 8 * fq;
            const float rs = rowss ? rstd_of(rowss[r]) : 1.f;
#pragma unroll
            for (int bj = 0; bj < 2; ++bj) { f32x4 v0 = acc[ai][bj][m][0] * cs[bj][0] * rs, v1 = acc[ai][bj][m][1] * cs[bj][1] * rs;
                if (ACT == 1) {
#pragma unroll
                    for (int j = 0; j < 4; ++j) { v0[j] = gelu_tanh(v0[j]); v1[j] = gelu_tanh(v1[j]); } }
                u32x4 o; o.x = pk_bf16(v0[0], v0[1]); o.y = pk_bf16(v0[2], v0[3]); o.z = pk_bf16(v1[0], v1[1]); o.w = pk_bf16(v1[2], v1[3]);
                *(u32x4*)(rowp + bj * HALF) = o; } }
}
struct EpiSwiglu {
    static constexpr bool PERM = true; static constexpr int MIDK = 0;
    bf16_t* O; const LAS float* tab;
    __device__ __forceinline__ void operator()(const f32x4 (&acc)[2][2][4][2], const Unit& u, int wr, int wc, int fr, int fq) const {
        char* basep = (char*)O + (((size_t)(u.pn * 2 + (wc >> 1)) * MTOK + (size_t)u.pm * BM + wr * 64 + fr) * 64 + (wc & 1) * 32 + 8 * fq) * 2;
#pragma unroll
        for (int ai = 0; ai < 2; ++ai)
#pragma unroll
            for (int m = 0; m < 4; ++m) { const int rl = ai * HALF + wr * 64 + m * 16 + fr;
                const float rs = tab[u.round * 256 + rl];
                f32x4 r0, r1;
#pragma unroll
                for (int j = 0; j < 4; ++j) { r0[j] = silu(acc[ai][0][m][0][j] * rs) * (acc[ai][1][m][0][j] * rs); r1[j] = silu(acc[ai][0][m][1][j] * rs) * (acc[ai][1][m][1][j] * rs); }
                u32x4 o; o.x = pk_bf16(r0[0], r0[1]); o.y = pk_bf16(r0[2], r0[3]); o.z = pk_bf16(r1[0], r1[1]); o.w = pk_bf16(r1[2], r1[3]);
                *(u32x4*)(basep + (ai * HALF + m * 16) * 128) = o; }
    }
};
template <int MK> struct EpiResid {
    static constexpr bool PERM = true; static constexpr int MIDK = MK;
    bf16_t* hb; float* ss; const LAS float* tab; float alpha;
    __device__ __forceinline__ void mid(f32x4 (&acc)[2][2][4][2], const Unit& u, int wr, int fr) const {
#pragma unroll
        for (int ai = 0; ai < 2; ++ai)
#pragma unroll
            for (int m = 0; m < 4; ++m) { const float ratio = tab[(u.round & 1) * 512 + ai * HALF + wr * 64 + m * 16 + fr];
#pragma unroll
                for (int bj = 0; bj < 2; ++bj)
#pragma unroll
                    for (int n = 0; n < 2; ++n) acc[ai][bj][m][n] *= ratio; }
    }
    __device__ __forceinline__ void operator()(const f32x4 (&acc)[2][2][4][2], const Unit& u, int wr, int wc, int fr, int fq) const {
        const int row0 = u.pm * BM + wr * 64 + fr, col0 = u.pn * BM + wc * 32 + 8 * fq;
#pragma unroll
        for (int ai = 0; ai < 2; ++ai)
#pragma unroll
            for (int m = 0; m < 4; ++m) { const int row = row0 + ai * HALF + m * 16; const size_t ro = (size_t)row * DM + col0; float sq = 0.f;
                const float al = (MK > 0) ? alpha * tab[(u.round & 1) * 512 + 256 + ai * HALF + wr * 64 + m * 16 + fr] : alpha;
#pragma unroll
                for (int bj = 0; bj < 2; ++bj) { const u32x4 hv = *(const u32x4*)(hb + ro + bj * HALF);
                    f32x4 s0 = (f32x4){bf_lo(hv.x), bf_hi(hv.x), bf_lo(hv.y), bf_hi(hv.y)}, s1 = (f32x4){bf_lo(hv.z), bf_hi(hv.z), bf_lo(hv.w), bf_hi(hv.w)};
                    s0 += acc[ai][bj][m][0] * al; s1 += acc[ai][bj][m][1] * al;
                    u32x4 o; o.x = pk_bf16(s0.x, s0.y); o.y = pk_bf16(s0.z, s0.w); o.z = pk_bf16(s1.x, s1.y); o.w = pk_bf16(s1.z, s1.w); *(u32x4*)(hb + ro + bj * HALF) = o;
                    sq += ((s0.x * s0.x + s0.y * s0.y) + (s0.z * s0.z + s0.w * s0.w)) + ((s1.x * s1.x + s1.y * s1.y) + (s1.z * s1.z + s1.w * s1.w)); }
                sq += __shfl_xor(sq, 16); sq += __shfl_xor(sq, 32); if (fq == 0) atomicAdd(ss + row, sq); }
    }
};
struct EpiMixIn {
    static constexpr bool PERM = true; static constexpr int MIDK = 0;
    unsigned char* ws; const float* ss;
    __device__ __forceinline__ void operator()(const f32x4 (&acc)[2][2][4][2], const Unit& u, int wr, int wc, int fr, int fq) const {
        size_t off; int ld, pn = u.pn; float scale = 1.f; bool act = false; const float* rowss = nullptr; const float* colss = nullptr;
        if (u.sub == 0) { rowss = ss + u.pm * BM;
            if (pn < 8) { off = WS_ZA; ld = 2048; act = true; }
            else if (pn < 12) { off = WS_QB; ld = 1024; pn -= 8; scale = 0.08838834764831845f * 1.4426950408889634f; }
            else { off = WS_KB; ld = 1024; pn -= 12; }
        } else if (u.sub == 1) { off = WS_VT; ld = MTOK; colss = ss + u.pn * BM; }
        else { ld = 2048; if (pn < 8) off = WS_KV; else { off = WS_VTX; pn -= 8; } }
        bf16_t* tile = (bf16_t*)(ws + off) + (size_t)u.pm * BM * ld + pn * BM;
        if (act) store_bf16_tile<1>(acc, tile, ld, 1.f, rowss, colss, wr, wc, fr, fq);
        else store_bf16_tile<0>(acc, tile, ld, scale, rowss, colss, wr, wc, fr, fq);
    }
};
struct CrossPrepOrder {
    const bf16_t* kx; const bf16_t* vx; const bf16_t* wcq; const bf16_t* wcot; int G, c; size_t lda, ldb; static constexpr size_t KSA = 128, KSB = 128;
    __device__ __forceinline__ bool next(int i, Unit& u) const {
        const long L = (long)i * G + c; if (L >= 512) return false;
        const int x = (int)L & 7, j = (int)L >> 3, sub = j >> 5, jj = j & 31, h = x & 3, b = (x >> 2) * 4 + (jj & 3), t8 = jj >> 2;
        u.sub = sub; u.aux = h; u.round = i;
        if (sub == 0) { u.pm = b; u.pn = t8; u.A = (const char*)(kx + (size_t)b * 256 * DM + h * 512); u.B = (const char*)(wcq + (size_t)t8 * 256 * DM + h * 512); }
        else { u.pm = t8; u.pn = b; u.A = (const char*)(wcot + (size_t)t8 * 256 * DM + h * 512); u.B = (const char*)(vx + (size_t)b * 256 * DM + h * 512); }
        return true;
    }
};
struct EpiCrossPrep {
    static constexpr bool PERM = true; static constexpr int MIDK = 0;
    bf16_t* mt; bf16_t* vwt;
    __device__ __forceinline__ void operator()(const f32x4 (&acc)[2][2][4][2], const Unit& u, int wr, int wc, int fr, int fq) const {
        if (u.sub == 0) store_bf16_tile<0>(acc, mt + ((size_t)u.pm * 1024 + u.aux * 256) * DM + u.pn * 256, DM, 1.f, nullptr, nullptr, wr, wc, fr, fq);
        else store_bf16_tile<0>(acc, vwt + ((size_t)u.pn * DM + u.pm * 256) * 1024 + u.aux * 256, 1024, 1.f, nullptr, nullptr, wr, wc, fr, fq);
    }
};
struct CrossSOrder {
    const bf16_t* hb; const bf16_t* mt; int G, c; size_t lda, ldb; static constexpr size_t KSA = 128, KSB = 128;
    __device__ __forceinline__ bool next(int i, Unit& u) const {
        const long L = (long)i * G + c; if (L >= 256) return false;
        const int b = (int)L & 7, j = (int)L >> 3, h = j & 3, mtile = j >> 2;
        u.A = (const char*)(hb + ((size_t)b * SEQ + 256 * mtile) * DM); u.B = (const char*)(mt + ((size_t)b * 1024 + h * 256) * DM); u.pm = b * 8 + mtile; u.pn = h; u.sub = 0; u.round = i; u.aux = 0; return true;
    }
};
struct EpiSoftmax {
    static constexpr bool PERM = true; static constexpr int MIDK = 0;
    bf16_t* P; LAS float* xch; const float* ss; float scale;
    __device__ __forceinline__ void operator()(f32x4 (&acc)[2][2][4][2], const Unit& u, int wr, int wc, int fr, int fq) const {
        float st[2][4];
#pragma unroll
        for (int ai = 0; ai < 2; ++ai)
#pragma unroll
            for (int m = 0; m < 4; ++m) { float v = -3.0e38f; const float rs = rstd_of(ss[u.pm * BM + ai * HALF + wr * 64 + m * 16 + fr]) * scale;
#pragma unroll
                for (int bj = 0; bj < 2; ++bj)
#pragma unroll
                    for (int n = 0; n < 2; ++n) { acc[ai][bj][m][n] *= rs;
#pragma unroll
                        for (int j = 0; j < 4; ++j) v = fmaxf(v, acc[ai][bj][m][n][j]); }
                v = fmaxf(v, __shfl_xor(v, 16)); v = fmaxf(v, __shfl_xor(v, 32)); st[ai][m] = v; }
        if (fq == 0) {
#pragma unroll
            for (int ai = 0; ai < 2; ++ai)
#pragma unroll
                for (int m = 0; m < 4; ++m) xch[(ai * HALF + wr * 64 + m * 16 + fr) * 4 + wc] = st[ai][m]; }
        LDS_WAIT(); __builtin_amdgcn_s_barrier();
#pragma unroll
        for (int ai = 0; ai < 2; ++ai)
#pragma unroll
            for (int m = 0; m < 4; ++m) { const f32x4 t = *(const LAS f32x4*)(xch + (ai * HALF + wr * 64 + m * 16 + fr) * 4); const float mx = fmaxf(fmaxf(t.x, t.y), fmaxf(t.z, t.w)); float s = 0.f;
#pragma unroll
                for (int bj = 0; bj < 2; ++bj)
#pragma unroll
                    for (int n = 0; n < 2; ++n)
#pragma unroll
                        for (int j = 0; j < 4; ++j) { const float e = __builtin_amdgcn_exp2f(acc[ai][bj][m][n][j] - mx); acc[ai][bj][m][n][j] = e; s += e; }
                s += __shfl_xor(s, 16); s += __shfl_xor(s, 32); st[ai][m] = s; }
        if (fq == 0) {
#pragma unroll
            for (int ai = 0; ai < 2; ++ai)
#pragma unroll
                for (int m = 0; m < 4; ++m) xch[1024 + (ai * HALF + wr * 64 + m * 16 + fr) * 4 + wc] = st[ai][m]; }
        LDS_WAIT(); __builtin_amdgcn_s_barrier();
#pragma unroll
        for (int ai = 0; ai < 2; ++ai)
#pragma unroll
            for (int m = 0; m < 4; ++m) { const f32x4 t = *(const LAS f32x4*)(xch + 1024 + (ai * HALF + wr * 64 + m * 16 + fr) * 4); const float inv = 1.f / ((t.x + t.y) + (t.z + t.w));
                bf16_t* rowp = P + (size_t)(u.pm * BM + ai * HALF + wr * 64 + m * 16 + fr) * 1024 + u.pn * 256 + wc * 32 + 8 * fq;
#pragma unroll
                for (int bj = 0; bj < 2; ++bj) { const f32x4 v0 = acc[ai][bj][m][0] * inv, v1 = acc[ai][bj][m][1] * inv;
                    u32x4 o; o.x = pk_bf16(v0[0], v0[1]); o.y = pk_bf16(v0[2], v0[3]); o.z = pk_bf16(v1[0], v1[1]); o.w = pk_bf16(v1[2], v1[3]);
                    *(u32x4*)(rowp + bj * HALF) = o; } }
    }
};
struct CrossOutOrder {
    const bf16_t* P; const bf16_t* vwt; int G, c; size_t lda, ldb; static constexpr size_t KSA = 128, KSB = 128;
    __device__ __forceinline__ bool next(int i, Unit& u) const {
        const long L = (long)i * G + c; if (L >= 512) return false;
        const int b = (int)L & 7, j = (int)L >> 3, nt = j & 7, mtile = j >> 3;
        u.A = (const char*)(P + ((size_t)b * SEQ + 256 * mtile) * 1024); u.B = (const char*)(vwt + ((size_t)b * DM + 256 * nt) * 1024); u.pm = b * 8 + mtile; u.pn = nt; u.sub = 0; u.round = i; u.aux = 0; return true;
    }
};
struct EpiNone { static constexpr bool PERM = true; static constexpr int MIDK = 0; float* sink;
    __device__ __forceinline__ void operator()(const f32x4 (&acc)[2][2][4][2], const Unit& u, int wr, int wc, int fr, int fq) const {
        float s = 0.f;
#pragma unroll
        for (int ai = 0; ai < 2; ++ai)
#pragma unroll
            for (int bj = 0; bj < 2; ++bj)
#pragma unroll
                for (int m = 0; m < 4; ++m)
#pragma unroll
                    for (int n = 0; n < 2; ++n) s += acc[ai][bj][m][n][0] + acc[ai][bj][m][n][1] + acc[ai][bj][m][n][2] + acc[ai][bj][m][n][3];
        if (s == 123.456f) *sink = s; } };
struct EpiBf16 {
    static constexpr bool PERM = true; static constexpr int MIDK = 0;
    bf16_t* O; int ld; float scale; const float* ss;
    __device__ __forceinline__ void operator()(const f32x4 (&acc)[2][2][4][2], const Unit& u, int wr, int wc, int fr, int fq) const {
        store_bf16_tile<0>(acc, O + (size_t)u.pm * BM * ld + u.pn * BM, ld, scale, ss ? ss + u.pm * BM : nullptr, nullptr, wr, wc, fr, fq);
    }
};
}

struct TrItem { const float* W; bf16_t* WT; const float* gain; const float* gainhi; int K, N, mode, item, blocked; };
__device__ __forceinline__ void tr_load(const TrItem& t, float (&r)[32], int lane) {
    const int nblk = t.N / 32, kb = t.item / nblk, nb = t.item % nblk; const float* src = t.W + (size_t)(64 * kb + (lane >> 5)) * t.N + 32 * nb + (lane & 31);
#pragma unroll
    for (int i = 0; i < 32; ++i) r[i] = src[(size_t)(2 * i) * t.N];
}
__device__ __forceinline__ void tr_store(const TrItem& t, LAS float* scr, int lane) {
    const int nblk = t.N / 32, kb = t.item / nblk, nb = t.item % nblk, k0 = 64 * kb, n0 = 32 * nb;
    int d0 = n0;
    if (t.mode == 1) { const int bj = n0 / DFF, rr = n0 % DFF; d0 = 256 * (rr / 128) + 128 * bj + (rr % 128); }
    LDS_WAIT();
    const int c = lane & 7;
    f32x4 g0 = {1.f, 1.f, 1.f, 1.f}, g1 = g0;
    if (t.gain) { const float* gp = (t.gainhi && k0 >= 1024) ? t.gainhi - 1024 : t.gain; g0 = *(const f32x4*)(gp + k0 + 8 * c); g1 = *(const f32x4*)(gp + k0 + 8 * c + 4); }
#pragma unroll
    for (int j = 0; j < 4; ++j) { const int n = (lane >> 3) + 8 * j; const LAS float* s = scr + (8 * c) * 33 + n;
        u32x4 o; o.x = pk_bf16(s[0 * 33] * g0.x, s[1 * 33] * g0.y); o.y = pk_bf16(s[2 * 33] * g0.z, s[3 * 33] * g0.w); o.z = pk_bf16(s[4 * 33] * g1.x, s[5 * 33] * g1.y); o.w = pk_bf16(s[6 * 33] * g1.z, s[7 * 33] * g1.w);
        bf16_t* dst = t.blocked ? t.WT + ((size_t)kb * t.N + d0 + n) * 64 + 8 * c : t.WT + (size_t)(d0 + n) * t.K + k0 + 8 * c;
        *(u32x4*)dst = o; }
    LDS_WAIT();
}
__device__ __forceinline__ void rms_row_to_bf16(const float* xrow, const float* gain, bf16_t* orow, int lane) {
    const f32x4* xr = (const f32x4*)xrow + lane; const f32x4* gr = (const f32x4*)gain + lane;
    f32x4 v[8]; float s = 0.f;
#pragma unroll
    for (int j = 0; j < 8; ++j) { v[j] = xr[64 * j]; s += (v[j].x * v[j].x + v[j].y * v[j].y) + (v[j].z * v[j].z + v[j].w * v[j].w); }
    const float rstd = rsqrtf(wave_sum(s) * (1.f / DM) + EPS);
    u32x2* o8 = (u32x2*)orow + lane;
#pragma unroll
    for (int j = 0; j < 8; ++j) { const f32x4 g = gr[64 * j]; u32x2 o; o.x = pk_bf16(v[j].x * rstd * g.x, v[j].y * rstd * g.y); o.y = pk_bf16(v[j].z * rstd * g.z, v[j].w * rstd * g.w); o8[64 * j] = o; }
}
__device__ __forceinline__ void rms_rows_phase(const float* src, const float* gain, bf16_t* dst, int rows, int gw, int ngw, int lane) {
    for (int r = gw; r < rows; r += ngw) rms_row_to_bf16(src + (size_t)r * DM, gain, dst + (size_t)r * DM, lane);
}

__device__ __forceinline__ bool tr_pick(const Params& p, int it, TrItem& t) {
    constexpr int I_IN = (DM / 64) * (2 * DFF / 32), I_OUT = (DFF / 64) * (DM / 32), I_MIXIN = (DM / 64) * (5120 / 32), I_SQ = (DM / 64) * (DM / 32), I_CKV = (DM / 64) * (4096 / 32);
    constexpr int NITEMS = 2 * I_IN + 2 * I_OUT + I_MIXIN + 2 * I_SQ + I_CKV;
    if (it >= NITEMS) return false;
    int r = it; t.gain = nullptr; t.gainhi = nullptr; t.mode = 0; t.blocked = 0;
    if (r < I_IN) { t.W = p.ffn1_w_in; t.WT = (bf16_t*)(p.ws + WS_WT_IN1); t.K = DM; t.N = 2 * DFF; t.mode = 1; t.gain = p.ffn1_norm; t.item = r; return true; } r -= I_IN;
    if (r < I_OUT) { t.W = p.ffn1_w_out; t.WT = (bf16_t*)(p.ws + WS_WT_OUT1); t.K = DFF; t.N = DM; t.blocked = 1; t.item = r; return true; } r -= I_OUT;
    if (r < I_MIXIN) { t.W = p.w_mix_in; t.WT = (bf16_t*)(p.ws + WS_WT_MIXIN); t.K = DM; t.N = 5120; t.gain = p.mix_norm; t.item = r; return true; } r -= I_MIXIN;
    if (r < I_SQ) { t.W = p.w_mix_out; t.WT = (bf16_t*)(p.ws + WS_WT_MIXOUT); t.K = DM; t.N = DM; t.gain = p.gnorm_a; t.gainhi = p.gnorm_b; t.item = r; return true; } r -= I_SQ;
    if (r < I_CKV) { t.W = p.w_ckv; t.WT = (bf16_t*)(p.ws + WS_WT_CKV); t.K = DM; t.N = 4096; t.item = r; return true; } r -= I_CKV;
    if (r < I_SQ) { t.W = p.w_co; t.WT = (bf16_t*)(p.ws + WS_WT_CO); t.K = DM; t.N = DM; t.item = r; return true; } r -= I_SQ;
    if (r < I_IN) { t.W = p.ffn2_w_in; t.WT = (bf16_t*)(p.ws + WS_WT_IN2); t.K = DM; t.N = 2 * DFF; t.mode = 1; t.gain = p.ffn2_norm; t.item = r; return true; } r -= I_IN;
    t.W = p.ffn2_w_out; t.WT = (bf16_t*)(p.ws + WS_WT_OUT2); t.K = DFF; t.N = DM; t.blocked = 1; t.item = r; return true;
}
__device__ __forceinline__ void phase_prologue(const Params& p, LAS unsigned char* lds, int gw, int ngw, int wave, int lane) {
    LAS float* scr = (LAS float*)(lds + wave * 16384);
    { float* ssz = (float*)(p.ws + WS_SS) + MTOK; for (int i = gw * 64 + lane; i < 6 * MTOK; i += ngw * 64) ssz[i] = 0.f; }
    TrItem cur, nxt; float r[32];
    bool have = tr_pick(p, gw, cur);
    if (have) tr_load(cur, r, lane);
    for (int it = gw; have; it += ngw) {
        const bool hn = tr_pick(p, it + ngw, nxt);
#pragma unroll
        for (int i = 0; i < 32; ++i) scr[(2 * i + (lane >> 5)) * 33 + (lane & 31)] = r[i];
        if (hn) tr_load(nxt, r, lane);
        tr_store(cur, scr, lane);
        cur = nxt; have = hn;
    }
    for (int r = gw; r < MTOK; r += ngw) {
        const f32x4* xr = (const f32x4*)(p.x + (size_t)r * DM) + lane; u32x2* o8 = (u32x2*)((bf16_t*)(p.ws + WS_HB) + (size_t)r * DM) + lane; float s = 0.f;
        f32x4 v[8];
#pragma unroll
        for (int j = 0; j < 8; ++j) { v[j] = xr[64 * j]; s += (v[j].x * v[j].x + v[j].y * v[j].y) + (v[j].z * v[j].z + v[j].w * v[j].w); }
#pragma unroll
        for (int j = 0; j < 8; ++j) { u32x2 o; o.x = pk_bf16(v[j].x, v[j].y); o.y = pk_bf16(v[j].z, v[j].w); o8[64 * j] = o; }
        s = wave_sum(s); if (lane == 0) ((float*)(p.ws + WS_SS))[r] = s;
    }
    rms_rows_phase(p.mem, p.mem_norm, (bf16_t*)(p.ws + WS_MEMN), MEMROWS, gw, ngw, lane);
    for (int r = gw; r < DM; r += ngw) {
        const f32x4* xr = (const f32x4*)(p.w_cq + (size_t)r * DM) + lane; u32x2* o8 = (u32x2*)((bf16_t*)(p.ws + WS_WT_CQ) + (size_t)r * DM) + lane; const float gk = p.cross_norm[r];
#pragma unroll
        for (int j = 0; j < 8; ++j) { const f32x4 v = xr[64 * j]; u32x2 o; o.x = pk_bf16(v.x * gk, v.y * gk); o.y = pk_bf16(v.z * gk, v.w * gk); o8[64 * j] = o; }
    }
}

__device__ __forceinline__ void phase_final_norm(const Params& p, int gw, int ngw, int lane) {
    const bf16_t* H = (const bf16_t*)(p.ws + WS_HB); const float* ss4 = (const float*)(p.ws + WS_SS) + 4 * MTOK;
    for (int r = gw; r < MTOK; r += ngw) {
        const u32x4* hr = (const u32x4*)(H + (size_t)r * DM) + lane; f32x4* orow = (f32x4*)(p.out + (size_t)r * DM);
        const float rs = rstd_of(ss4[r]);
#pragma unroll
        for (int j = 0; j < 4; ++j) { const u32x4 h = hr[64 * j]; const int c4 = (64 * j + lane) * 2; const f32x4 g0 = ((const f32x4*)p.final_norm)[c4], g1 = ((const f32x4*)p.final_norm)[c4 + 1];
            __builtin_nontemporal_store((f32x4){bf_lo(h.x) * rs * g0.x, bf_hi(h.x) * rs * g0.y, bf_lo(h.y) * rs * g0.z, bf_hi(h.y) * rs * g0.w}, orow + c4);
            __builtin_nontemporal_store((f32x4){bf_lo(h.z) * rs * g1.x, bf_hi(h.z) * rs * g1.y, bf_lo(h.w) * rs * g1.z, bf_hi(h.w) * rs * g1.w}, orow + c4 + 1); }
    }
}

__device__ __forceinline__ void phase_ynorm(const Params& p, int gw, int ngw, int lane) {
    bf16_t* Y = (bf16_t*)(p.ws + WS_XN);
    for (int r = gw; r < MTOK; r += ngw) {
        u32x4* yr = (u32x4*)(Y + (size_t)r * DM) + lane;
        u32x4 v[4]; float ss[2] = {0.f, 0.f};
#pragma unroll
        for (int j = 0; j < 4; ++j) { v[j] = yr[64 * j]; float s = 0.f;
#pragma unroll
            for (int e = 0; e < 4; ++e) { const float a = bf_lo(v[j][e]), b = bf_hi(v[j][e]); s += a * a + b * b; }
            ss[j >> 1] += s; }
        const float ra = rsqrtf(wave_sum(ss[0]) * (1.f / 1024) + EPS), rb = rsqrtf(wave_sum(ss[1]) * (1.f / 1024) + EPS);
#pragma unroll
        for (int j = 0; j < 4; ++j) { const float rs = (j < 2) ? ra : rb; const float* g = ((j < 2) ? p.gnorm_a : p.gnorm_b) + (j & 1) * 512 + lane * 8;
            const f32x4 g0 = *(const f32x4*)g, g1 = *(const f32x4*)(g + 4); u32x4 o;
            o.x = pk_bf16(bf_lo(v[j].x) * rs * g0.x, bf_hi(v[j].x) * rs * g0.y); o.y = pk_bf16(bf_lo(v[j].y) * rs * g0.z, bf_hi(v[j].y) * rs * g0.w);
            o.z = pk_bf16(bf_lo(v[j].z) * rs * g1.x, bf_hi(v[j].z) * rs * g1.y); o.w = pk_bf16(bf_lo(v[j].w) * rs * g1.z, bf_hi(v[j].w) * rs * g1.w);
            yr[64 * j] = o; }
    }
}

__device__ __forceinline__ void phase_sgu_mfma(const Params& p, LAS unsigned char* lds, int wave, int lane, int first, int stride) {
    constexpr int VS = 272;
    const bf16_t* za = (const bf16_t*)(p.ws + WS_ZA); bf16_t* Y = (bf16_t*)(p.ws + WS_XN);
    const int l32 = lane & 31, hh = lane >> 5, tt = wave >> 1, cpair = wave & 1;
    for (int item = first; item < NB * 16 * 8; item += stride) {
        const int g = item & 7, n = (item >> 3) & 15, b = item >> 7; const size_t row0 = (size_t)b * SEQ + n * 128;
        const int t = 32 * tt + l32;
        unsigned vv[16];
#pragma unroll
        for (int r = 0; r < 16; ++r) vv[r] = *(const unsigned*)(za + (row0 + wave + 8 * r) * 2048 + 1024 + g * 128 + 2 * lane);
        const float* wrow = p.spatial_w + ((size_t)g * 128 + t) * 128 + 8 * hh;
        f32x4 w0[8], w1[8];
#pragma unroll
        for (int ks = 0; ks < 8; ++ks) if (ks < 4 || tt >= 2) { w0[ks] = *(const f32x4*)(wrow + 16 * ks); w1[ks] = *(const f32x4*)(wrow + 16 * ks + 4); }
        u32x2 uu[2][4];
#pragma unroll
        for (int ci = 0; ci < 2; ++ci)
#pragma unroll
            for (int cg4 = 0; cg4 < 4; ++cg4) uu[ci][cg4] = *(const u32x2*)(za + (row0 + t) * 2048 + g * 128 + 32 * (2 * cpair + ci) + 8 * cg4 + 4 * hh);
        const float bias = p.spatial_b[g * 128 + t]; float sqa = 0.f;
        const float g0 = p.ln_v_gain[g * 128 + 2 * lane], g1 = p.ln_v_gain[g * 128 + 2 * lane + 1], b0 = p.ln_v_bias[g * 128 + 2 * lane], b1 = p.ln_v_bias[g * 128 + 2 * lane + 1];
#pragma unroll
        for (int r = 0; r < 16; ++r) { const int s = wave + 8 * r;
            const float a = bf_lo(vv[r]), c = bf_hi(vv[r]);
            const float mu = wave_sum(a + c) * (1.f / 128); const float da = a - mu, dc = c - mu;
            const float var = wave_sum(da * da + dc * dc) * (1.f / 128); const float rstd = rsqrtf(var + EPS);
            const unsigned o = pk_bf16(da * rstd * g0 + b0, dc * rstd * g1 + b1);
            *(LAS bf16_t*)(lds + (2 * lane) * VS + s * 2) = (bf16_t)(o & 0xffffu); *(LAS bf16_t*)(lds + (2 * lane + 1) * VS + s * 2) = (bf16_t)(o >> 16);
        }
        __syncthreads();
        f32x16 acc[2];
#pragma unroll
        for (int i = 0; i < 16; ++i) { acc[0][i] = 0.f; acc[1][i] = 0.f; }
#pragma unroll
        for (int ks = 0; ks < 8; ++ks) if (ks < 4 || tt >= 2) {
            u32x4 wb; wb.x = pk_bf16(w0[ks].x, w0[ks].y); wb.y = pk_bf16(w0[ks].z, w0[ks].w); wb.z = pk_bf16(w1[ks].x, w1[ks].y); wb.w = pk_bf16(w1[ks].z, w1[ks].w);
            const bf16x8 bfrag = __builtin_bit_cast(bf16x8, wb);
#pragma unroll
            for (int ci = 0; ci < 2; ++ci) { const bf16x8 a = *(const LAS bf16x8*)(lds + (32 * (2 * cpair + ci) + l32) * VS + (16 * ks + 8 * hh) * 2); acc[ci] = MFMA32(a, bfrag, acc[ci]); }
        }
#pragma unroll
        for (int ci = 0; ci < 2; ++ci)
#pragma unroll
            for (int cg4 = 0; cg4 < 4; ++cg4) { const int c = 32 * (2 * cpair + ci) + 8 * cg4 + 4 * hh; const size_t o = (row0 + t) * 2048 + g * 128 + c;
                const u32x2 u2 = uu[ci][cg4]; u32x2 r;
                r.x = pk_bf16(bf_lo(u2.x) * (acc[ci][4 * cg4] + bias), bf_hi(u2.x) * (acc[ci][4 * cg4 + 1] + bias));
                r.y = pk_bf16(bf_lo(u2.y) * (acc[ci][4 * cg4 + 2] + bias), bf_hi(u2.y) * (acc[ci][4 * cg4 + 3] + bias));
                *(u32x2*)(Y + o) = r;
                sqa += (bf_lo(r.x) * bf_lo(r.x) + bf_hi(r.x) * bf_hi(r.x)) + (bf_lo(r.y) * bf_lo(r.y) + bf_hi(r.y) * bf_hi(r.y)); }
        sqa += __shfl_xor(sqa, 32); if (hh == 0) atomicAdd((float*)(p.ws + WS_SS) + 5 * MTOK + row0 + t, sqa);
        __syncthreads();
    }
}
__device__ __forceinline__ void phase_stick_mfma(const Params& p, LAS unsigned char* lds, int wave, int lane) {
    constexpr int KSTR = 272, VSTR = 136, KBYTES = 64 * KSTR, BUFB = KBYTES + 128 * VSTR;
    const bf16_t* qb = (const bf16_t*)(p.ws + WS_QB); const bf16_t* kb = (const bf16_t*)(p.ws + WS_KB); const bf16_t* vT = (const bf16_t*)(p.ws + WS_VT);
    bf16_t* Y = (bf16_t*)(p.ws + WS_XN);
    const int tid = opaque_tid(), l32 = lane & 31, hh = lane >> 5;
    for (int item = blockIdx.x; item < 256; item += gridDim.x) {
        const int pr = item & 3, head = (item >> 2) & 7, b = item >> 5;
        const bf16_t* kbase = kb + (size_t)b * SEQ * 1024 + head * 128;
        const bf16_t* vbase = vT + (size_t)(head * 128) * MTOK + (size_t)b * SEQ;
        for (int pass = 0; pass < 2; ++pass) {
            const int I = pass ? pr : 7 - pr;
            const int tw = 256 * I + 32 * wave;
            bf16x8 qf[8];
            { const bf16_t* qrow = qb + ((size_t)b * SEQ + tw + l32) * 1024 + head * 128 + 8 * hh;
#pragma unroll
              for (int kd = 0; kd < 8; ++kd) qf[kd] = *(const bf16x8*)(qrow + 16 * kd); }
            f32x16 oacc[4];
#pragma unroll
            for (int dt = 0; dt < 4; ++dt)
#pragma unroll
                for (int i = 0; i < 16; ++i) oacc[dt][i] = 0.f;
            float R = 0.f;
            const int jmax = 4 * I + 3;
            u32x4 kr[2], vr[2];
            unsigned koff[2], voff[2];
#pragma unroll
            for (int i_ = 0; i_ < 2; ++i_) { const int c_ = tid + 512 * i_; koff[i_] = (unsigned)(((64 * jmax + (c_ >> 4)) * 1024 + (c_ & 15) * 8) * 2); voff[i_] = (unsigned)((c_ >> 3) * (MTOK * 2) + (64 * jmax + (c_ & 7) * 8) * 2); }
#define STK_LOAD() do { _Pragma("unroll") for (int i_ = 0; i_ < 2; ++i_) { kr[i_] = *(const u32x4*)((const char*)kbase + koff[i_]); vr[i_] = *(const u32x4*)((const char*)vbase + voff[i_]); koff[i_] -= 64 * 1024 * 2; voff[i_] -= 128; } } while (0)
            STK_LOAD();
            for (int j = jmax; j >= 0; --j) {
                LAS unsigned char* bufp = lds + (j & 1) * BUFB;
#pragma unroll
                for (int i_ = 0; i_ < 2; ++i_) { const int c_ = tid + 512 * i_;
                    *(LAS u32x4*)(bufp + (c_ >> 4) * KSTR + (c_ & 15) * 16) = kr[i_];
                    LAS u32x2* vp = (LAS u32x2*)(bufp + KBYTES + (c_ >> 3) * VSTR + (c_ & 7) * 16); vp[0] = (u32x2){vr[i_].x, vr[i_].y}; vp[1] = (u32x2){vr[i_].z, vr[i_].w}; }
                const bool alive = __builtin_amdgcn_ballot_w64(R >= -160.f) != 0ull;
                if (lane == 0) *(volatile LAS unsigned*)(lds + 2 * BUFB + ((j & 1) * 8 + wave) * 4) = alive ? 1u : 0u;
                __syncthreads();
                { const u32x4 f0 = *(const LAS u32x4*)(lds + 2 * BUFB + (j & 1) * 32), f1 = *(const LAS u32x4*)(lds + 2 * BUFB + (j & 1) * 32 + 16);
                  if (((f0.x | f0.y) | (f0.z | f0.w) | (f1.x | f1.y) | (f1.z | f1.w)) == 0u) break; }
                if (j > 0) STK_LOAD();
                const int k0 = 64 * j;
                if (alive && k0 <= tw + 30) {
                    const bool diag = (k0 + 63 >= tw); const int t = tw + l32;
                    float run = R;
#pragma unroll
                    for (int ks = 1; ks >= 0; --ks) {
                        f32x16 s, lm;
#pragma unroll
                        for (int i = 0; i < 16; ++i) s[i] = 0.f;
#pragma unroll
                        for (int kd = 0; kd < 8; ++kd) { const bf16x8 a = *(const LAS bf16x8*)(bufp + (32 * ks + l32) * KSTR + (16 * kd + 8 * hh) * 2); s = MFMA32(a, qf[kd], s); }
                        if (diag) {
#pragma unroll
                            for (int i = 0; i < 16; ++i) { const int key = k0 + 32 * ks + 8 * (i >> 2) + 4 * hh + (i & 3); if (key >= t) s[i] = -1.0e30f; } }
#pragma unroll
                        for (int i = 0; i < 16; ++i) { const float z = s[i]; const float e = __builtin_amdgcn_exp2f(-fabsf(z)); lm[i] = -(fmaxf(z, 0.f) + __builtin_amdgcn_logf(1.f + e)); }
                        float gs[4], og[4];
#pragma unroll
                        for (int c4 = 0; c4 < 4; ++c4) { gs[c4] = (lm[4 * c4] + lm[4 * c4 + 1]) + (lm[4 * c4 + 2] + lm[4 * c4 + 3]); og[c4] = __shfl_xor(gs[c4], 32); }
#pragma unroll
                        for (int c4 = 3; c4 >= 0; --c4) {
                            const float r3 = run + (hh == 0 ? og[c4] : 0.f);
                            const float r2 = r3 + lm[4 * c4 + 3], r1 = r2 + lm[4 * c4 + 2], r0 = r1 + lm[4 * c4 + 1];
                            s[4 * c4 + 3] = __builtin_amdgcn_exp2f(s[4 * c4 + 3] + lm[4 * c4 + 3] + r3);
                            s[4 * c4 + 2] = __builtin_amdgcn_exp2f(s[4 * c4 + 2] + lm[4 * c4 + 2] + r2);
                            s[4 * c4 + 1] = __builtin_amdgcn_exp2f(s[4 * c4 + 1] + lm[4 * c4 + 1] + r1);
                            s[4 * c4] = __builtin_amdgcn_exp2f(s[4 * c4] + lm[4 * c4] + r0);
                            run += gs[c4] + og[c4]; }
#pragma unroll
                        for (int kk = 0; kk < 2; ++kk) {
                            u32x4 pw; pw.x = pk_bf16(s[8 * kk], s[8 * kk + 1]); pw.y = pk_bf16(s[8 * kk + 2], s[8 * kk + 3]); pw.z = pk_bf16(s[8 * kk + 4], s[8 * kk + 5]); pw.w = pk_bf16(s[8 * kk + 6], s[8 * kk + 7]);
                            const bf16x8 pf = __builtin_bit_cast(bf16x8, pw);
#pragma unroll
                            for (int dt = 0; dt < 4; ++dt) { const LAS unsigned char* va = bufp + KBYTES + (32 * dt + l32) * VSTR + (32 * ks + 16 * kk + 4 * hh) * 2;
                                const u32x2 v0 = *(const LAS u32x2*)va, v1 = *(const LAS u32x2*)(va + 16);
                                const u32x4 vw = {v0.x, v0.y, v1.x, v1.y};
                                oacc[dt] = MFMA32(__builtin_bit_cast(bf16x8, vw), pf, oacc[dt]); } }
                    }
                    R = run;
                }
            }
#undef STK_LOAD
            __syncthreads();
            bf16_t* yrow = Y + ((size_t)b * SEQ + tw + l32) * 2048 + 1024 + head * 128 + 4 * hh; float sqb = 0.f;
#pragma unroll
            for (int dt = 0; dt < 4; ++dt)
#pragma unroll
                for (int c4 = 0; c4 < 4; ++c4) { u32x2 r; r.x = pk_bf16(oacc[dt][4 * c4], oacc[dt][4 * c4 + 1]); r.y = pk_bf16(oacc[dt][4 * c4 + 2], oacc[dt][4 * c4 + 3]); *(u32x2*)(yrow + 32 * dt + 8 * c4) = r;
                    sqb += (bf_lo(r.x) * bf_lo(r.x) + bf_hi(r.x) * bf_hi(r.x)) + (bf_lo(r.y) * bf_lo(r.y) + bf_hi(r.y) * bf_hi(r.y)); }
            sqb += __shfl_xor(sqb, 32); if (hh == 0) atomicAdd((float*)(p.ws + WS_SS) + 6 * MTOK + (size_t)b * SEQ + tw + l32, sqb);
        }
    }
}

#define XB_TMO      128
#define XB_XCNT(j)  (256  + 64 * (j))
#define XB_XSUB(j)  (1280 + 64 * (j))
#define XB_XGEN(j)  (2304 + 64 * (j))
#define XB_TOP      3328
#define XB_TOPGEN   3392
#define XCD_BAR_WORDS 3456
#define XB_SPIN_CAP (1u << 20)
__device__ __forceinline__ unsigned xb_ld(unsigned* p)              { return __hip_atomic_load(p, __ATOMIC_RELAXED, __HIP_MEMORY_SCOPE_AGENT); }
__device__ __forceinline__ unsigned xb_add(unsigned* p, unsigned v) { return __hip_atomic_fetch_add(p, v, __ATOMIC_RELAXED, __HIP_MEMORY_SCOPE_AGENT); }
__device__ __forceinline__ unsigned xb_xcc_id() { return (unsigned)__builtin_amdgcn_s_getreg((3 << 11) | 20) & 0xFu; }
#define XB_SPIN(cond, bar) do { unsigned _sp = 0; while (cond) { __builtin_amdgcn_s_sleep(1); \
    if ((++_sp & 255u) == 0u) { if (xb_ld(&(bar)[XB_TMO])) break; if (_sp > XB_SPIN_CAP) { atomicAdd(&(bar)[XB_TMO], 1u); break; } } } } while (0)
__device__ __forceinline__ void xcd_barrier_post(unsigned* bar) { if (threadIdx.x == 0) (void)xb_add(&bar[XB_XCNT(xb_xcc_id())], 1u); }
__device__ __forceinline__ void xcd_barrier_complete(unsigned* bar, unsigned x, unsigned& nloc, unsigned& nx) {
    const unsigned G = gridDim.x * gridDim.y * gridDim.z;
    unsigned sum, cnt, mine, sp = 0u;
    for (;;) {
        sum = 0u; cnt = 0u; mine = 0u;
#pragma unroll
        for (unsigned j = 0; j < 16; ++j) { const unsigned c = xb_ld(&bar[XB_XCNT(j)]); sum += c; cnt += (c > 0u) ? 1u : 0u; mine = (j == x) ? c : mine; }
        if (sum == G) break;
        __builtin_amdgcn_s_sleep(1);
        if ((++sp & 255u) == 0u) { if (xb_ld(&bar[XB_TMO])) break; if (sp > XB_SPIN_CAP) { atomicAdd(&bar[XB_TMO], 1u); break; } }
    }
    nloc = mine > 0u ? mine : 1u; nx = cnt > 0u ? cnt : 1u;
}
__device__ __forceinline__ void xcd_barrier(unsigned* bar, volatile LAS unsigned* st) {
    asm volatile("s_waitcnt vmcnt(0)" ::: "memory");
    __syncthreads();
    if (threadIdx.x == 0) {
        const unsigned x = xb_xcc_id();
        __builtin_amdgcn_s_waitcnt(0);
        unsigned nloc = st[0], nx = st[1];
        if (nloc == 0u) { xcd_barrier_complete(bar, x, nloc, nx); st[0] = nloc; st[1] = nx; }
        const unsigned old = xb_add(&bar[XB_XSUB(x)], 1u);
        const unsigned gen = old / nloc;
        if (old + 1u == (gen + 1u) * nloc) {
            __builtin_amdgcn_fence(__ATOMIC_RELEASE, "agent");
            asm volatile("s_waitcnt vmcnt(0)" ::: "memory");
            const unsigned og = xb_add(&bar[XB_TOP], 1u);
            const unsigned tg = og / nx;
            if (og + 1u == (tg + 1u) * nx) xb_add(&bar[XB_TOPGEN], 1u);
            else XB_SPIN(xb_ld(&bar[XB_TOPGEN]) == tg, bar);
            __builtin_amdgcn_fence(__ATOMIC_ACQUIRE, "agent");
            xb_add(&bar[XB_XGEN(x)], 1u);
            asm volatile("s_waitcnt vmcnt(0)" ::: "memory");
        } else {
            XB_SPIN(xb_ld(&bar[XB_XGEN(x)]) == gen, bar);
            __builtin_amdgcn_fence(__ATOMIC_ACQUIRE, "agent");
            asm volatile("s_waitcnt vmcnt(0)" ::: "memory");
        }
    }
    __syncthreads();
}

constexpr int NPHASES = 12;
constexpr int LDS_BYTES = 144 * 1024;

__global__ __launch_bounds__(512, 2) void mega(Params p) {
    extern __shared__ __attribute__((aligned(16))) unsigned char shm[];
    LAS unsigned char* lds = (LAS unsigned char*)shm;
    cg::grid_group grid = cg::this_grid();
    const int ngw = gridDim.x * 8;
    unsigned* const xbar = (unsigned*)(p.ws + WS_BAR);
    volatile LAS unsigned* const xst = (volatile LAS unsigned*)(lds + LDS_BYTES - 16);
    if (threadIdx.x == 0) { xst[0] = 0u; xst[1] = 0u; }
    __syncthreads();
    xcd_barrier_post(xbar);
    const int G = gridDim.x, c = blockIdx.x;
    unsigned char* ws = p.ws;
#define PH_BEGIN(n) if (p.ph_lo <= (n) && (n) < p.ph_hi) { const int tid_ = opaque_tid(); const int wave = tid_ >> 6, lane = tid_ & 63, gw = blockIdx.x * 8 + wave; (void)gw; (void)lane;
#define PH_END(n) } if (p.ph_lo <= (n) && (n) + 1 < p.ph_hi) { if (p.ph_hi > NPHASES) grid.sync(); else xcd_barrier(xbar, xst); }
#define GEMM_SWIGLU(AOFF, WOFF, SSP) { pg8::MultiOrder<1> S; S.s[0] = {(const bf16_t*)(ws + (AOFF)), (const bf16_t*)(ws + (WOFF)), 64, 44}; S.G = G; S.c = c; S.lda = DM; S.ldb = DM; \
        LAS float* tab = (LAS float*)(lds + pg8::STAGE_BYTES); \
        for (int e_ = tid_; e_ < 11 * 256; e_ += 512) { pg8::Unit u_; if (S.next(e_ >> 8, u_)) tab[e_] = rstd_of((SSP)[u_.pm * 256 + (e_ & 255)]); } __syncthreads(); \
        pg8::EpiSwiglu E{(bf16_t*)(ws + WS_ACT), tab}; pg8::gemm_phase(lds, DM, S, E); }
#define GEMM_RESID(MK, AOFF, WOFF, KK, ALPHA, SSP) { pg8::MultiOrder<1> S; S.s[0] = {(const bf16_t*)(ws + (AOFF)), (const bf16_t*)(ws + (WOFF)), 64, 8}; S.G = G; S.c = c; S.lda = (KK); S.ldb = (KK); \
        LAS float* tab = (LAS float*)(lds + pg8::STAGE_BYTES); \
        if (MK > 0) { const int rnd = tid_ >> 8, rl = tid_ & 255; pg8::Unit u_; if (S.next(rnd, u_)) { const int row = u_.pm * 256 + rl; \
            const float ra = rsqrtf(ss0[5 * MTOK + row] * (1.f / 1024) + EPS), rb = rsqrtf(ss0[6 * MTOK + row] * (1.f / 1024) + EPS); tab[rnd * 512 + rl] = ra / rb; tab[rnd * 512 + 256 + rl] = rb; } __syncthreads(); } \
        pg8::EpiResid<MK> E{(bf16_t*)(ws + WS_HB), (SSP), tab, (ALPHA)}; pg8::gemm_phase(lds, (KK), S, E); }
#define GEMM_FFN_OUT(WOFF, ALPHA, SSP) { pg8::MultiOrder<1, (size_t)MTOK * 128, (size_t)DM * 128> S; S.s[0] = {(const bf16_t*)(ws + WS_ACT), (const bf16_t*)(ws + (WOFF)), 64, 8}; S.G = G; S.c = c; S.lda = 64; S.ldb = 64; \
        pg8::EpiResid<0> E{(bf16_t*)(ws + WS_HB), (SSP), (LAS float*)(lds + pg8::STAGE_BYTES), (ALPHA)}; pg8::gemm_phase(lds, DFF, S, E); }
    float* const ss0 = (float*)(ws + WS_SS); float* const ss1 = ss0 + MTOK; float* const ss2 = ss1 + MTOK; float* const ss3 = ss2 + MTOK; float* const ss4 = ss3 + MTOK;
    PH_BEGIN(0) phase_prologue(p, lds, gw, ngw, wave, lane); PH_END(0)
#ifdef PROBE_DUP0
    PH_BEGIN(0) phase_prologue(p, lds, gw, ngw, wave, lane); PH_END(0)
#endif
    PH_BEGIN(1) GEMM_SWIGLU(WS_HB, WS_WT_IN1, ss0) PH_END(1)
    PH_BEGIN(2) GEMM_FFN_OUT(WS_WT_OUT1, 0.5f, ss1) PH_END(2)
    PH_BEGIN(3) {
        pg8::MultiOrder<2> S; const bf16_t* hn = (const bf16_t*)(ws + WS_HB); const bf16_t* wm = (const bf16_t*)(ws + WS_WT_MIXIN);
        S.s[0] = {hn, wm, 64, 16}; S.s[1] = {wm + (size_t)4096 * DM, hn, 4, 64};
        S.G = G; S.c = c; S.lda = DM; S.ldb = DM;
        pg8::EpiMixIn E{ws, ss1};
        pg8::gemm_phase(lds, DM, S, E); } PH_END(3)
    PH_BEGIN(4) {
        phase_stick_mfma(p, lds, wave, lane); __syncthreads();
        const int ng = G >> 1;
        if (c < ng) {
            pg8::MultiOrder<4> S; const bf16_t* mn = (const bf16_t*)(ws + WS_MEMN); const bf16_t* wkv = (const bf16_t*)(ws + WS_WT_CKV);
            S.s[0] = {mn, wkv, 0, 8}; S.s[1] = {mn, wkv, 0, 8}; S.s[2] = {mn, wkv, 8, 16}; S.s[3] = {mn, wkv, 0, 8};
            S.G = ng; S.c = c; S.lda = DM; S.ldb = DM;
            pg8::EpiMixIn E{ws, ss1};
            pg8::gemm_phase(lds, DM, S, E);
        } else phase_sgu_mfma(p, lds, wave, lane, c - ng, G - ng); } PH_END(4)
    PH_BEGIN(5) GEMM_RESID(16, WS_XN, WS_WT_MIXOUT, DM, 1.f, ss2) PH_END(5)
    PH_BEGIN(6) {
        pg8::CrossPrepOrder S{(const bf16_t*)(ws + WS_KV), (const bf16_t*)(ws + WS_VTX), (const bf16_t*)(ws + WS_WT_CQ), (const bf16_t*)(ws + WS_WT_CO), G, c, (size_t)DM, (size_t)DM};
        pg8::EpiCrossPrep E{(bf16_t*)(ws + WS_MT), (bf16_t*)(ws + WS_VWT)};
        pg8::gemm_phase(lds, 512, S, E); } PH_END(6)
    PH_BEGIN(7) {
        pg8::CrossSOrder S{(const bf16_t*)(ws + WS_HB), (const bf16_t*)(ws + WS_MT), G, c, (size_t)DM, (size_t)DM};
        pg8::EpiSoftmax E{(bf16_t*)(ws + WS_P), (LAS float*)(lds + pg8::STAGE_BYTES), ss2, 0.04419417382415922f * 1.4426950408889634f};
        pg8::gemm_phase(lds, DM, S, E); } PH_END(7)
    PH_BEGIN(8) {
        pg8::CrossOutOrder S{(const bf16_t*)(ws + WS_P), (const bf16_t*)(ws + WS_VWT), G, c, (size_t)1024, (size_t)1024};
        pg8::EpiResid<0> E{(bf16_t*)(ws + WS_HB), ss3, (LAS float*)(lds + pg8::STAGE_BYTES), 1.f};
        pg8::gemm_phase(lds, 1024, S, E); } PH_END(8)
    PH_BEGIN(9) GEMM_SWIGLU(WS_HB, WS_WT_IN2, ss3) PH_END(9)
    PH_BEGIN(10) GEMM_FFN_OUT(WS_WT_OUT2, 0.5f, ss4) PH_END(10)
    PH_BEGIN(11) phase_final_norm(p, gw, ngw, lane); PH_END(11)
}

extern "C" void kernel_launch(void* const* d_in, const int* in_sizes, int n_in, void* d_out, int out_size, void* d_ws, size_t ws_size, hipStream_t stream) {
    static int grid = 0;
    if (grid == 0) {
        if (n_in != 23 || out_size != MTOK * DM || ws_size < WS_END) { fprintf(stderr, "kernel_launch: unexpected problem (n_in %d out %d ws %zu, need %zu)\n", n_in, out_size, ws_size, (size_t)WS_END); grid = -1; return; }
        int dev = 0, cus = 0, per_cu = 0;
        hipGetDevice(&dev); hipDeviceGetAttribute(&cus, hipDeviceAttributeMultiprocessorCount, dev);
        if (hipFuncSetAttribute((const void*)mega, hipFuncAttributeMaxDynamicSharedMemorySize, LDS_BYTES) != hipSuccess) { fprintf(stderr, "kernel_launch: hipFuncSetAttribute failed\n"); grid = -1; return; }
        if (hipOccupancyMaxActiveBlocksPerMultiprocessor(&per_cu, (const void*)mega, 512, LDS_BYTES) != hipSuccess || per_cu < 1) { fprintf(stderr, "kernel_launch: occupancy query says %d\n", per_cu); per_cu = 1; }
        (void)hipGetLastError();
        grid = cus * per_cu;
    }
    if (grid < 0) return;
    Params p{};
    const float** pp = (const float**)&p;
    for (int i = 0; i < 23; ++i) pp[i] = (const float*)d_in[i];
    p.out = (float*)d_out; p.ws = (unsigned char*)d_ws; p.ph_lo = 0; p.ph_hi = NPHASES;
    if (hipMemsetAsync((unsigned char*)d_ws + WS_BAR, 0, 3456 * 4, stream) != hipSuccess) { fprintf(stderr, "kernel_launch: memset of the barrier words failed\n"); return; }
    void* args[] = {&p};
    hipError_t e = hipLaunchCooperativeKernel((const void*)mega, dim3(grid), dim3(512), args, LDS_BYTES, stream);
    if (e != hipSuccess) fprintf(stderr, "kernel_launch: cooperative launch failed: %s (grid %d)\n", hipGetErrorString(e), grid);
}
```

```cpp
#include <hip/hip_runtime.h>
#include <hip/hip_cooperative_groups.h>
#include <cstdio>
namespace cg = cooperative_groups;

#define LAS __attribute__((address_space(3)))
typedef unsigned short bf16_t;
typedef short bf16x8 __attribute__((ext_vector_type(8)));
typedef float f32x4 __attribute__((ext_vector_type(4)));
typedef float f32x2 __attribute__((ext_vector_type(2)));
typedef unsigned u32x4 __attribute__((ext_vector_type(4)));
typedef unsigned u32x2 __attribute__((ext_vector_type(2)));

constexpr int MTOK = 16384, DM = 2048, DFF = 5632, SEQ = 2048, NB = 8, NMEM = 256, MEMROWS = NB * NMEM;
constexpr float EPS = 1e-6f;
constexpr size_t MiB = 1024 * 1024;
constexpr size_t WS_WT_IN1 = 0;
constexpr size_t WS_WT_OUT1 = WS_WT_IN1 + 44 * MiB;
constexpr size_t WS_WT_MIXIN = WS_WT_OUT1 + 22 * MiB;
constexpr size_t WS_WT_MIXOUT = WS_WT_MIXIN + 20 * MiB;
constexpr size_t WS_WT_CQ = WS_WT_MIXOUT + 8 * MiB;
constexpr size_t WS_WT_CKV = WS_WT_CQ + 8 * MiB;
constexpr size_t WS_WT_CO = WS_WT_CKV + 16 * MiB;
constexpr size_t WS_WT_IN2 = WS_WT_CO + 8 * MiB;
constexpr size_t WS_WT_OUT2 = WS_WT_IN2 + 44 * MiB;
constexpr size_t WS_XN = WS_WT_OUT2 + 22 * MiB;
constexpr size_t WS_HB = WS_XN + 64 * MiB;
constexpr size_t WS_ACT = WS_HB + 64 * MiB;
constexpr size_t WS_ZA = WS_ACT;
constexpr size_t WS_QB = WS_ZA + 64 * MiB;
constexpr size_t WS_KB = WS_QB + 32 * MiB;
constexpr size_t WS_VT = WS_KB + 32 * MiB;
constexpr size_t WS_MT = WS_ACT;
constexpr size_t WS_VWT = WS_MT + 32 * MiB;
constexpr size_t WS_P = WS_VWT + 32 * MiB;
constexpr size_t WS_MEMN = WS_ACT + 176 * MiB;
constexpr size_t WS_KV = WS_MEMN + 8 * MiB;
constexpr size_t WS_VTX = WS_KV + 8 * MiB;
constexpr size_t WS_SS = WS_VTX + 8 * MiB;
constexpr size_t WS_BAR = WS_SS + 512 * 1024;
constexpr size_t WS_END = WS_SS + 1 * MiB;

struct Params {
    const float* x; const float* mem; const float* ffn1_norm; const float* ffn1_w_in; const float* ffn1_w_out; const float* mix_norm; const float* w_mix_in;
    const float* ln_v_gain; const float* ln_v_bias; const float* spatial_w; const float* spatial_b; const float* gnorm_a; const float* gnorm_b; const float* w_mix_out;
    const float* cross_norm; const float* mem_norm; const float* w_cq; const float* w_ckv; const float* w_co; const float* ffn2_norm; const float* ffn2_w_in;
    const float* ffn2_w_out; const float* final_norm;
    float* out; unsigned char* ws; int ph_lo, ph_hi;
};

typedef __bf16 bf16x2_t __attribute__((ext_vector_type(2)));
typedef float f32x16 __attribute__((ext_vector_type(16)));
__device__ __forceinline__ unsigned pk_bf16(float lo, float hi) { f32x2 v = {lo, hi}; bf16x2_t r = __builtin_convertvector(v, bf16x2_t); return __builtin_bit_cast(unsigned, r); }
#define MFMA32(a, b, c) __builtin_amdgcn_mfma_f32_32x32x16_bf16((a), (b), (c), 0, 0, 0)
__device__ __forceinline__ float bf_lo(unsigned u) { return __uint_as_float(u << 16); }
__device__ __forceinline__ float bf_hi(unsigned u) { return __uint_as_float(u & 0xffff0000u); }
__device__ __forceinline__ float wave_sum(float v) {
#pragma unroll
    for (int o = 1; o < 64; o <<= 1) v += __shfl_xor(v, o);
    return v;
}
__device__ __forceinline__ float wave_max(float v) {
#pragma unroll
    for (int o = 1; o < 64; o <<= 1) v = fmaxf(v, __shfl_xor(v, o));
    return v;
}
__device__ __forceinline__ float gelu_tanh(float x) { const float u2 = -2.302208198f * (x + 0.044715f * x * x * x); return x * __builtin_amdgcn_rcpf(1.f + __builtin_amdgcn_exp2f(u2)); }
__device__ __forceinline__ float silu(float g) { return g * __builtin_amdgcn_rcpf(1.f + __builtin_amdgcn_exp2f(-1.4426950408889634f * g)); }
__device__ __forceinline__ float rstd_of(float ss) { return rsqrtf(ss * (1.f / DM) + EPS); }
__device__ __forceinline__ int opaque_tid() { int t = threadIdx.x; asm volatile("" : "+v"(t)); return t; }
#define LDS_WAIT() asm volatile("s_waitcnt lgkmcnt(0)" ::: "memory")

namespace pg8 {
constexpr int BM = 256, BK = 64, HALF = 128, HTB = HALF * BK * 2, STAGE_BYTES = 8 * HTB, NXCD = 8, WGM = 8;
__device__ __forceinline__ int lds_byte(int r, int c) { const int st = (r >> 4) * 2 + (c >> 5), rr = r & 15, cc = c & 31, ob = rr * 64 + cc * 2; return st * 1024 + (ob ^ (((ob >> 9) & 1) << 5)); }
__device__ __forceinline__ void stage_rc(int b, int& R, int& C) { const int st = b / 1024, sb = b % 1024, swz = sb ^ (((sb >> 9) & 1) << 5); R = (st >> 1) * 16 + swz / 64; C = (st & 1) * 32 + (swz % 64) / 2; }
__device__ __forceinline__ int perm32(int rho) { const int n = rho >> 4, i = rho & 15; return 8 * (i >> 2) + 4 * n + (i & 3); }

struct Unit { const char* A; const char* B; int pm, pn, sub, round, aux; };
struct SubG { const bf16_t* A; const bf16_t* B; int nM, nN; };

template <int NS, size_t KSA_ = 128, size_t KSB_ = 128> struct MultiOrder {
    static constexpr size_t KSA = KSA_, KSB = KSB_;
    SubG s[NS]; int G, c; size_t lda, ldb;
    __device__ __forceinline__ bool next(int i, Unit& u) const {
        long L = (long)i * G + c;
#pragma unroll
        for (int j = 0; j < NS; ++j) {
            const int nM = s[j].nM, nN = s[j].nN, nwg = nM * nN;
            if (L < nwg) {
                int wgid = (int)L; { const int q = nwg / NXCD, r = nwg % NXCD, xcd = wgid % NXCD, off = wgid / NXCD; wgid = (xcd < r ? xcd * (q + 1) : r * (q + 1) + (xcd - r) * q) + off; }
                const int nig = WGM * nN, gid = wgid / nig, fm = gid * WGM, gsz = (nM - fm) < WGM ? (nM - fm) : WGM;
                u.pm = fm + ((wgid % nig) % gsz); u.pn = (wgid % nig) / gsz; u.sub = j; u.round = i; u.aux = 0;
                u.A = (const char*)s[j].A + (size_t)u.pm * 256 * lda * 2; u.B = (const char*)s[j].B + (size_t)u.pn * 256 * ldb * 2;
                return true;
            }
            L -= nwg;
        }
        return false;
    }
};

#ifndef PG8_SP2
#define PG8_SP2 true
#endif
#ifndef PG8_ALIGN
#define PG8_ALIGN true
#endif
template <class Epi, class Sched, bool ALIGN_EPI = PG8_ALIGN, bool SP2 = PG8_SP2>
__device__ __forceinline__ void gemm_phase(LAS unsigned char* lds, const int K, const Sched S, const Epi E) {
    const int tid = opaque_tid(), wid = __builtin_amdgcn_readfirstlane(tid >> 6), lane = tid & 63, wr = wid >> 2, wc = wid & 3, fr = lane & 15, fq = lane >> 4;
    const int nt = K / BK;
    const int lda = (int)S.lda, ldb = (int)S.ldb;
    unsigned voffA[2], voffB[2];
#pragma unroll
    for (int i = 0; i < 2; ++i) { int R, C; stage_rc(tid * 16 + i * 8192, R, C); const int Rb = Epi::PERM ? ((R & ~31) + perm32(R & 31)) : R;
        voffA[i] = (unsigned)(R * lda + C) * 2u; voffB[i] = (unsigned)(Rb * ldb + C) * 2u; }
    constexpr size_t kstepA = Sched::KSA, kstepB = Sched::KSB;
    const size_t hstepA = (size_t)HALF * lda * 2, hstepB = (size_t)HALF * ldb * 2;
    const unsigned ldsw = (unsigned)wid * 1024u;
    const int aoff = lds_byte(wr * 64 + fr, fq * 8), boff = lds_byte(wc * 32 + fr, fq * 8);
#define PG8_SA(b, h) (((b) * 2 + (h)) * HTB)
#define PG8_SB(b, h) ((4 + (b) * 2 + (h)) * HTB)
#define PG8_STAGE(bufoff, gbase, voff) do { _Pragma("unroll") for (int _i = 0; _i < 2; ++_i) \
        __builtin_amdgcn_global_load_lds((const unsigned*)((const char*)(gbase) + (voff)[_i]), (LAS unsigned*)(lds + (bufoff) + ldsw + _i * 8192), 16, 0, 0); } while (0)
#define PG8_LDA(dst, b, h) do { _Pragma("unroll") for (int m = 0; m < 4; ++m) _Pragma("unroll") for (int k = 0; k < 2; ++k) dst[m][k] = *(const LAS bf16x8*)(lds + PG8_SA(b, h) + aoff + m * 2048 + k * 1024); } while (0)
#define PG8_LDB(dst, b, h) do { _Pragma("unroll") for (int n = 0; n < 2; ++n) _Pragma("unroll") for (int k = 0; k < 2; ++k) dst[n][k] = *(const LAS bf16x8*)(lds + PG8_SB(b, h) + boff + n * 2048 + k * 1024); } while (0)
#define PG8_MMA(ai, bj, At, Bt) do { __builtin_amdgcn_s_setprio(1); _Pragma("unroll") for (int m = 0; m < 4; ++m) _Pragma("unroll") for (int n = 0; n < 2; ++n) _Pragma("unroll") for (int k = 0; k < 2; ++k) \
        acc[ai][bj][m][n] = __builtin_amdgcn_mfma_f32_16x16x32_bf16(Bt[n][k], At[m][k], acc[ai][bj][m][n], 0, 0, 0); __builtin_amdgcn_s_setprio(0); } while (0)
#define PG8_MMA2(ai, bj, At, Bt, ai2, bj2, At2, Bt2) do { __builtin_amdgcn_s_setprio(1); _Pragma("unroll") for (int m = 0; m < 4; ++m) _Pragma("unroll") for (int n = 0; n < 2; ++n) _Pragma("unroll") for (int k = 0; k < 2; ++k) \
        acc[ai][bj][m][n] = __builtin_amdgcn_mfma_f32_16x16x32_bf16(Bt[n][k], At[m][k], acc[ai][bj][m][n], 0, 0, 0); \
        _Pragma("unroll") for (int m = 0; m < 4; ++m) _Pragma("unroll") for (int n = 0; n < 2; ++n) _Pragma("unroll") for (int k = 0; k < 2; ++k) \
        acc[ai2][bj2][m][n] = __builtin_amdgcn_mfma_f32_16x16x32_bf16(Bt2[n][k], At2[m][k], acc[ai2][bj2][m][n], 0, 0, 0); __builtin_amdgcn_s_setprio(0); } while (0)
#define PG8_WAIT_V(n) asm volatile("s_waitcnt vmcnt(" #n ")" ::: "memory")
#define PG8_WAIT_L(n) asm volatile("s_waitcnt lgkmcnt(" #n ")" ::: "memory")
#define PG8_BAR __builtin_amdgcn_s_barrier()
#define PG8_SCHED __builtin_amdgcn_sched_barrier(0)
    Unit cur, nxt; int ui = 0;
    if (!S.next(0, cur)) return;
    f32x4 acc[2][2][4][2];
#pragma unroll
    for (int a = 0; a < 2; ++a)
#pragma unroll
        for (int b = 0; b < 2; ++b)
#pragma unroll
            for (int m = 0; m < 4; ++m)
#pragma unroll
                for (int n = 0; n < 2; ++n) acc[a][b][m][n] = (f32x4){0.f, 0.f, 0.f, 0.f};
    bf16x8 At[4][2], B0[2][2], B1[2][2];
    const char* cA = cur.A; const char* cB = cur.B;
    if constexpr (SP2) {
        PG8_STAGE(PG8_SB(0, 0), cB, voffB); PG8_STAGE(PG8_SB(0, 1), cB + hstepB, voffB); PG8_STAGE(PG8_SA(0, 0), cA, voffA); PG8_STAGE(PG8_SA(0, 1), cA + hstepA, voffA);
        if (wr == 1) PG8_BAR;
        PG8_WAIT_V(2); PG8_BAR;
        PG8_STAGE(PG8_SB(1, 0), cB + kstepB, voffB); PG8_STAGE(PG8_SA(1, 0), cA + kstepA, voffA); PG8_STAGE(PG8_SB(1, 1), cB + hstepB + kstepB, voffB);
        PG8_WAIT_V(6); PG8_BAR;
    } else {
        PG8_STAGE(PG8_SB(0, 0), cB, voffB); PG8_STAGE(PG8_SA(0, 0), cA, voffA); PG8_STAGE(PG8_SB(0, 1), cB + hstepB, voffB); PG8_STAGE(PG8_SA(0, 1), cA + hstepA, voffA);
        if (wr == 1) PG8_BAR;
        PG8_WAIT_V(4); PG8_BAR;
        PG8_STAGE(PG8_SB(1, 0), cB + kstepB, voffB); PG8_STAGE(PG8_SA(1, 0), cA + kstepA, voffA); PG8_STAGE(PG8_SB(1, 1), cB + hstepB + kstepB, voffB);
        PG8_WAIT_V(6); PG8_BAR;
    }
    for (;;) {
        const bool has_next = S.next(ui + 1, nxt);
        const char* nA = has_next ? nxt.A : cA; const char* nB = has_next ? nxt.B : cB;
        for (int t = 0; t < nt; t += 2) {
            const bool last = (t == nt - 2);
            const char* a1 = cA + (size_t)(t + 1) * kstepA;
            const char* a2 = last ? nA : cA + (size_t)(t + 2) * kstepA; const char* b2 = last ? nB : cB + (size_t)(t + 2) * kstepB;
            const char* a3 = a2 + kstepA; const char* b3 = b2 + kstepB;
            if constexpr (Epi::MIDK > 0) { if (t == Epi::MIDK) E.mid(acc, cur, wr, fr); }
            if constexpr (SP2) {
            PG8_LDB(B0, 0, 0); PG8_LDB(B1, 0, 1); PG8_SCHED; PG8_LDA(At, 0, 0); PG8_STAGE(PG8_SA(1, 1), a1 + hstepA, voffA);
            PG8_WAIT_V(8); PG8_WAIT_L(0); PG8_BAR; PG8_MMA2(0, 0, At, B0, 0, 1, At, B1); PG8_BAR; PG8_SCHED;
            PG8_LDA(At, 0, 1); PG8_STAGE(PG8_SB(0, 0), b2, voffB); PG8_STAGE(PG8_SB(0, 1), b2 + hstepB, voffB); PG8_STAGE(PG8_SA(0, 0), a2, voffA);
            PG8_WAIT_V(8); PG8_WAIT_L(0); PG8_BAR; PG8_MMA2(1, 0, At, B0, 1, 1, At, B1); PG8_BAR; PG8_SCHED;
            PG8_LDB(B0, 1, 0); PG8_LDB(B1, 1, 1); PG8_SCHED; PG8_LDA(At, 1, 0); PG8_STAGE(PG8_SA(0, 1), a2 + hstepA, voffA);
            PG8_WAIT_V(8); PG8_WAIT_L(0); PG8_BAR; PG8_MMA2(0, 0, At, B0, 0, 1, At, B1); PG8_BAR; PG8_SCHED;
            PG8_LDA(At, 1, 1); PG8_STAGE(PG8_SB(1, 0), b3, voffB); PG8_STAGE(PG8_SB(1, 1), b3 + hstepB, voffB); PG8_STAGE(PG8_SA(1, 0), a3, voffA);
            PG8_WAIT_V(8); PG8_WAIT_L(0); PG8_BAR; PG8_MMA2(1, 0, At, B0, 1, 1, At, B1); PG8_BAR; PG8_SCHED;
            } else {
            PG8_LDB(B0, 0, 0); PG8_SCHED; PG8_LDA(At, 0, 0); PG8_STAGE(PG8_SA(1, 1), a1 + hstepA, voffA);
            PG8_WAIT_L(8); PG8_BAR; PG8_WAIT_L(0); PG8_MMA(0, 0, At, B0); PG8_BAR; PG8_SCHED;
            PG8_LDB(B1, 0, 1); PG8_STAGE(PG8_SB(0, 0), b2, voffB);
            PG8_BAR; PG8_WAIT_L(0); PG8_MMA(0, 1, At, B1); PG8_BAR;
            PG8_LDA(At, 0, 1); PG8_STAGE(PG8_SA(0, 0), a2, voffA);
            PG8_BAR; PG8_WAIT_L(0); PG8_MMA(1, 0, At, B0); PG8_BAR; PG8_SCHED;
            PG8_STAGE(PG8_SB(0, 1), b2 + hstepB, voffB);
            PG8_WAIT_V(6); PG8_BAR; PG8_MMA(1, 1, At, B1); PG8_BAR;
            PG8_LDB(B0, 1, 0); PG8_SCHED; PG8_LDA(At, 1, 0); PG8_STAGE(PG8_SA(0, 1), a2 + hstepA, voffA);
            PG8_WAIT_L(8); PG8_BAR; PG8_WAIT_L(0); PG8_MMA(0, 0, At, B0); PG8_BAR; PG8_SCHED;
            PG8_LDB(B1, 1, 1); PG8_STAGE(PG8_SB(1, 0), b3, voffB);
            PG8_BAR; PG8_WAIT_L(0); PG8_MMA(0, 1, At, B1); PG8_BAR;
            PG8_LDA(At, 1, 1); PG8_STAGE(PG8_SA(1, 0), a3, voffA);
            PG8_BAR; PG8_WAIT_L(0); PG8_MMA(1, 0, At, B0); PG8_BAR; PG8_SCHED;
            PG8_STAGE(PG8_SB(1, 1), b3 + hstepB, voffB);
            PG8_WAIT_V(6); PG8_BAR; PG8_MMA(1, 1, At, B1); PG8_BAR;
                    }
        }
        if constexpr (ALIGN_EPI) { if (wr == 0) PG8_BAR; }
        E(acc, cur, wr, wc, fr, fq);
        if (!has_next) break;
#pragma unroll
        for (int a = 0; a < 2; ++a)
#pragma unroll
            for (int b = 0; b < 2; ++b)
#pragma unroll
                for (int m = 0; m < 4; ++m)
#pragma unroll
                    for (int n = 0; n < 2; ++n) acc[a][b][m][n] = (f32x4){0.f, 0.f, 0.f, 0.f};
        cur = nxt; cA = nA; cB = nB; ++ui;
        if constexpr (ALIGN_EPI) { if (wr == 1) PG8_BAR; }
    }
    PG8_WAIT_V(0);
    if constexpr (!ALIGN_EPI) { if (wr == 0) PG8_BAR; }
    PG8_BAR;
#undef PG8_SA
#undef PG8_SB
#undef PG8_STAGE
#undef PG8_LDA
#undef PG8_LDB
#undef PG8_MMA
#undef PG8_MMA2
#undef PG8_WAIT_V
#undef PG8_WAIT_L
#undef PG8_BAR
#undef PG8_SCHED
}

template <int ACT> __device__ __forceinline__ void store_bf16_tile(const f32x4 (&acc)[2][2][4][2], bf16_t* tile, size_t ld, float scale, const LAS float* rowrs, const LAS float* colrs, int wr, int wc, int fr, int fq) {
    f32x4 cs[2][2];
#pragma unroll
    for (int bj = 0; bj < 2; ++bj)
#pragma unroll
        for (int n = 0; n < 2; ++n) { cs[bj][n] = (f32x4){scale, scale, scale, scale};
            if (colrs) cs[bj][n] = *(const LAS f32x4*)(colrs + bj * HALF + wc * 32 + 8 * fq + 4 * n) * scale; }
#pragma unroll
    for (int ai = 0; ai < 2; ++ai)
#pragma unroll
        for (int m = 0; m < 4; ++m) { const int r = ai * HALF + wr * 64 + m * 16 + fr; bf16_t* rowp = tile + (size_t)r * ld + wc * 32 + 8 * fq;
            const float rs = rowrs ? rowrs[r] : 1.f;
#pragma unroll
            for (int bj = 0; bj < 2; ++bj) { f32x4 v0 = acc[ai][bj][m][0] * cs[bj][0] * rs, v1 = acc[ai][bj][m][1] * cs[bj][1] * rs;
                if (ACT == 1) {
#pragma unroll
                    for (int j = 0; j < 4; ++j) { v0[j] = gelu_tanh(v0[j]); v1[j] = gelu_tanh(v1[j]); } }
                u32x4 o; o.x = pk_bf16(v0[0], v0[1]); o.y = pk_bf16(v0[2], v0[3]); o.z = pk_bf16(v1[0], v1[1]); o.w = pk_bf16(v1[2], v1[3]);
                *(u32x4*)(rowp + bj * HALF) = o; } }
}
struct EpiSwiglu {
    static constexpr bool PERM = true; static constexpr int MIDK = 0;
    bf16_t* O; const LAS float* tab;
    __device__ __forceinline__ void operator()(const f32x4 (&acc)[2][2][4][2], const Unit& u, int wr, int wc, int fr, int fq) const {
        char* basep = (char*)O + (((size_t)(u.pn * 2 + (wc >> 1)) * MTOK + (size_t)u.pm * BM + wr * 64 + fr) * 64 + (wc & 1) * 32 + 8 * fq) * 2;
#pragma unroll
        for (int ai = 0; ai < 2; ++ai)
#pragma unroll
            for (int m = 0; m < 4; ++m) { const int rl = ai * HALF + wr * 64 + m * 16 + fr;
                const float rs = tab[u.round * 256 + rl];
                f32x4 r0, r1;
#pragma unroll
                for (int j = 0; j < 4; ++j) { r0[j] = silu(acc[ai][0][m][0][j] * rs) * (acc[ai][1][m][0][j] * rs); r1[j] = silu(acc[ai][0][m][1][j] * rs) * (acc[ai][1][m][1][j] * rs); }
                u32x4 o; o.x = pk_bf16(r0[0], r0[1]); o.y = pk_bf16(r0[2], r0[3]); o.z = pk_bf16(r1[0], r1[1]); o.w = pk_bf16(r1[2], r1[3]);
                *(u32x4*)(basep + (ai * HALF + m * 16) * 128) = o; }
    }
};
template <int MK> struct EpiResid {
    static constexpr bool PERM = true; static constexpr int MIDK = MK;
    bf16_t* hb; float* ss; const LAS float* tab; float alpha;
    __device__ __forceinline__ void mid(f32x4 (&acc)[2][2][4][2], const Unit& u, int wr, int fr) const {
#pragma unroll
        for (int ai = 0; ai < 2; ++ai)
#pragma unroll
            for (int m = 0; m < 4; ++m) { const float ratio = tab[(u.round & 1) * 512 + ai * HALF + wr * 64 + m * 16 + fr];
#pragma unroll
                for (int bj = 0; bj < 2; ++bj)
#pragma unroll
                    for (int n = 0; n < 2; ++n) acc[ai][bj][m][n] *= ratio; }
    }
    __device__ __forceinline__ void operator()(const f32x4 (&acc)[2][2][4][2], const Unit& u, int wr, int wc, int fr, int fq) const {
        const int row0 = u.pm * BM + wr * 64 + fr, col0 = u.pn * BM + wc * 32 + 8 * fq;
#pragma unroll
        for (int ai = 0; ai < 2; ++ai)
#pragma unroll
            for (int m = 0; m < 4; ++m) { const int row = row0 + ai * HALF + m * 16; const size_t ro = (size_t)row * DM + col0; float sq = 0.f;
                const float al = (MK > 0) ? alpha * tab[(u.round & 1) * 512 + 256 + ai * HALF + wr * 64 + m * 16 + fr] : alpha;
#pragma unroll
                for (int bj = 0; bj < 2; ++bj) { const u32x4 hv = *(const u32x4*)(hb + ro + bj * HALF);
                    f32x4 s0 = (f32x4){bf_lo(hv.x), bf_hi(hv.x), bf_lo(hv.y), bf_hi(hv.y)}, s1 = (f32x4){bf_lo(hv.z), bf_hi(hv.z), bf_lo(hv.w), bf_hi(hv.w)};
                    s0 += acc[ai][bj][m][0] * al; s1 += acc[ai][bj][m][1] * al;
                    u32x4 o; o.x = pk_bf16(s0.x, s0.y); o.y = pk_bf16(s0.z, s0.w); o.z = pk_bf16(s1.x, s1.y); o.w = pk_bf16(s1.z, s1.w); *(u32x4*)(hb + ro + bj * HALF) = o;
                    sq += ((s0.x * s0.x + s0.y * s0.y) + (s0.z * s0.z + s0.w * s0.w)) + ((s1.x * s1.x + s1.y * s1.y) + (s1.z * s1.z + s1.w * s1.w)); }
                sq += __shfl_xor(sq, 16); sq += __shfl_xor(sq, 32); if (fq == 0) atomicAdd(ss + row, sq); }
    }
};
struct EpiMixIn {
    static constexpr bool PERM = true; static constexpr int MIDK = 0;
    unsigned char* ws; const LAS float* tab;
    __device__ __forceinline__ void operator()(const f32x4 (&acc)[2][2][4][2], const Unit& u, int wr, int wc, int fr, int fq) const {
        size_t off; int ld, pn = u.pn; float scale = 1.f; bool act = false; const LAS float* rowrs = nullptr; const LAS float* colrs = nullptr;
        if (u.sub == 0) { rowrs = tab + u.round * 256;
            if (pn < 8) { off = WS_ZA; ld = 2048; act = true; }
            else if (pn < 12) { off = WS_QB; ld = 1024; pn -= 8; scale = 0.08838834764831845f * 1.4426950408889634f; }
            else { off = WS_KB; ld = 1024; pn -= 12; }
        } else if (u.sub == 1) { off = WS_VT; ld = MTOK; colrs = tab + u.round * 256; }
        else { ld = 2048; if (pn < 8) off = WS_KV; else { off = WS_VTX; pn -= 8; } }
        bf16_t* tile = (bf16_t*)(ws + off) + (size_t)u.pm * BM * ld + pn * BM;
        if (act) store_bf16_tile<1>(acc, tile, ld, 1.f, rowrs, colrs, wr, wc, fr, fq);
        else store_bf16_tile<0>(acc, tile, ld, scale, rowrs, colrs, wr, wc, fr, fq);
    }
};
struct CrossPrepOrder {
    const bf16_t* kx; const bf16_t* vx; const bf16_t* wcq; const bf16_t* wcot; int G, c; size_t lda, ldb; static constexpr size_t KSA = 128, KSB = 128;
    __device__ __forceinline__ bool next(int i, Unit& u) const {
        const long L = (long)i * G + c; if (L >= 512) return false;
        const int x = (int)L & 7, j = (int)L >> 3, sub = j >> 5, jj = j & 31, h = x & 3, b = (x >> 2) * 4 + (jj & 3), t8 = jj >> 2;
        u.sub = sub; u.aux = h; u.round = i;
        if (sub == 0) { u.pm = b; u.pn = t8; u.A = (const char*)(kx + (size_t)b * 256 * DM + h * 512); u.B = (const char*)(wcq + (size_t)t8 * 256 * DM + h * 512); }
        else { u.pm = t8; u.pn = b; u.A = (const char*)(wcot + (size_t)t8 * 256 * DM + h * 512); u.B = (const char*)(vx + (size_t)b * 256 * DM + h * 512); }
        return true;
    }
};
struct EpiCrossPrep {
    static constexpr bool PERM = true; static constexpr int MIDK = 0;
    bf16_t* mt; bf16_t* vwt;
    __device__ __forceinline__ void operator()(const f32x4 (&acc)[2][2][4][2], const Unit& u, int wr, int wc, int fr, int fq) const {
        if (u.sub == 0) store_bf16_tile<0>(acc, mt + ((size_t)u.pm * 1024 + u.aux * 256) * DM + u.pn * 256, DM, 1.f, nullptr, nullptr, wr, wc, fr, fq);
        else store_bf16_tile<0>(acc, vwt + ((size_t)u.pn * DM + u.pm * 256) * 1024 + u.aux * 256, 1024, 1.f, nullptr, nullptr, wr, wc, fr, fq);
    }
};
struct CrossSOrder {
    const bf16_t* hb; const bf16_t* mt; int G, c; size_t lda, ldb; static constexpr size_t KSA = 128, KSB = 128;
    __device__ __forceinline__ bool next(int i, Unit& u) const {
        const long L = (long)i * G + c; if (L >= 256) return false;
        const int b = (int)L & 7, j = (int)L >> 3, h = j & 3, mtile = j >> 2;
        u.A = (const char*)(hb + ((size_t)b * SEQ + 256 * mtile) * DM); u.B = (const char*)(mt + ((size_t)b * 1024 + h * 256) * DM); u.pm = b * 8 + mtile; u.pn = h; u.sub = 0; u.round = i; u.aux = 0; return true;
    }
};
struct EpiSoftmax {
    static constexpr bool PERM = true; static constexpr int MIDK = 0;
    bf16_t* P; LAS float* xch; const LAS float* rtab; float scale;
    __device__ __forceinline__ void operator()(f32x4 (&acc)[2][2][4][2], const Unit& u, int wr, int wc, int fr, int fq) const {
        float st[2][4];
#pragma unroll
        for (int ai = 0; ai < 2; ++ai)
#pragma unroll
            for (int m = 0; m < 4; ++m) { float v = -3.0e38f; const float rs = rtab[(u.round & 1) * 256 + ai * HALF + wr * 64 + m * 16 + fr] * scale;
#pragma unroll
                for (int bj = 0; bj < 2; ++bj)
#pragma unroll
                    for (int n = 0; n < 2; ++n) { acc[ai][bj][m][n] *= rs;
#pragma unroll
                        for (int j = 0; j < 4; ++j) v = fmaxf(v, acc[ai][bj][m][n][j]); }
                v = fmaxf(v, __shfl_xor(v, 16)); v = fmaxf(v, __shfl_xor(v, 32)); st[ai][m] = v; }
        if (fq == 0) {
#pragma unroll
            for (int ai = 0; ai < 2; ++ai)
#pragma unroll
                for (int m = 0; m < 4; ++m) xch[(ai * HALF + wr * 64 + m * 16 + fr) * 4 + wc] = st[ai][m]; }
        LDS_WAIT(); __builtin_amdgcn_s_barrier();
#pragma unroll
        for (int ai = 0; ai < 2; ++ai)
#pragma unroll
            for (int m = 0; m < 4; ++m) { const f32x4 t = *(const LAS f32x4*)(xch + (ai * HALF + wr * 64 + m * 16 + fr) * 4); const float mx = fmaxf(fmaxf(t.x, t.y), fmaxf(t.z, t.w)); float s = 0.f;
#pragma unroll
                for (int bj = 0; bj < 2; ++bj)
#pragma unroll
                    for (int n = 0; n < 2; ++n)
#pragma unroll
                        for (int j = 0; j < 4; ++j) { const float e = __builtin_amdgcn_exp2f(acc[ai][bj][m][n][j] - mx); acc[ai][bj][m][n][j] = e; s += e; }
                s += __shfl_xor(s, 16); s += __shfl_xor(s, 32); st[ai][m] = s; }
        if (fq == 0) {
#pragma unroll
            for (int ai = 0; ai < 2; ++ai)
#pragma unroll
                for (int m = 0; m < 4; ++m) xch[1024 + (ai * HALF + wr * 64 + m * 16 + fr) * 4 + wc] = st[ai][m]; }
        LDS_WAIT(); __builtin_amdgcn_s_barrier();
#pragma unroll
        for (int ai = 0; ai < 2; ++ai)
#pragma unroll
            for (int m = 0; m < 4; ++m) { const f32x4 t = *(const LAS f32x4*)(xch + 1024 + (ai * HALF + wr * 64 + m * 16 + fr) * 4); const float inv = 1.f / ((t.x + t.y) + (t.z + t.w));
                bf16_t* rowp = P + (size_t)(u.pm * BM + ai * HALF + wr * 64 + m * 16 + fr) * 1024 + u.pn * 256 + wc * 32 + 8 * fq;
#pragma unroll
                for (int bj = 0; bj < 2; ++bj) { const f32x4 v0 = acc[ai][bj][m][0] * inv, v1 = acc[ai][bj][m][1] * inv;
                    u32x4 o; o.x = pk_bf16(v0[0], v0[1]); o.y = pk_bf16(v0[2], v0[3]); o.z = pk_bf16(v1[0], v1[1]); o.w = pk_bf16(v1[2], v1[3]);
                    *(u32x4*)(rowp + bj * HALF) = o; } }
    }
};
struct CrossOutOrder {
    const bf16_t* P; const bf16_t* vwt; int G, c; size_t lda, ldb; static constexpr size_t KSA = 128, KSB = 128;
    __device__ __forceinline__ bool next(int i, Unit& u) const {
        const long L = (long)i * G + c; if (L >= 512) return false;
        const int b = (int)L & 7, j = (int)L >> 3, nt = j & 7, mtile = j >> 3;
        u.A = (const char*)(P + ((size_t)b * SEQ + 256 * mtile) * 1024); u.B = (const char*)(vwt + ((size_t)b * DM + 256 * nt) * 1024); u.pm = b * 8 + mtile; u.pn = nt; u.sub = 0; u.round = i; u.aux = 0; return true;
    }
};
struct EpiNone { static constexpr bool PERM = true; static constexpr int MIDK = 0; float* sink;
    __device__ __forceinline__ void operator()(const f32x4 (&acc)[2][2][4][2], const Unit& u, int wr, int wc, int fr, int fq) const {
        float s = 0.f;
#pragma unroll
        for (int ai = 0; ai < 2; ++ai)
#pragma unroll
            for (int bj = 0; bj < 2; ++bj)
#pragma unroll
                for (int m = 0; m < 4; ++m)
#pragma unroll
                    for (int n = 0; n < 2; ++n) s += acc[ai][bj][m][n][0] + acc[ai][bj][m][n][1] + acc[ai][bj][m][n][2] + acc[ai][bj][m][n][3];
        if (s == 123.456f) *sink = s; } };
struct EpiBf16 {
    static constexpr bool PERM = true; static constexpr int MIDK = 0;
    bf16_t* O; int ld; float scale;
    __device__ __forceinline__ void operator()(const f32x4 (&acc)[2][2][4][2], const Unit& u, int wr, int wc, int fr, int fq) const {
        store_bf16_tile<0>(acc, O + (size_t)u.pm * BM * ld + u.pn * BM, ld, scale, nullptr, nullptr, wr, wc, fr, fq);
    }
};
}

struct TrItem { const float* W; bf16_t* WT; const float* gain; const float* gainhi; int K, N, mode, item, blocked; };
__device__ __forceinline__ void tr_load(const TrItem& t, float (&r)[32], int lane) {
    const int nblk = t.N / 32, kb = t.item / nblk, nb = t.item % nblk; const float* src = t.W + (size_t)(64 * kb + (lane >> 5)) * t.N + 32 * nb + (lane & 31);
#pragma unroll
    for (int i = 0; i < 32; ++i) r[i] = src[(size_t)(2 * i) * t.N];
}
__device__ __forceinline__ void tr_store(const TrItem& t, LAS float* scr, int lane) {
    const int nblk = t.N / 32, kb = t.item / nblk, nb = t.item % nblk, k0 = 64 * kb, n0 = 32 * nb;
    int d0 = n0;
    if (t.mode == 1) { const int bj = n0 / DFF, rr = n0 % DFF; d0 = 256 * (rr / 128) + 128 * bj + (rr % 128); }
    LDS_WAIT();
    const int c = lane & 7;
    f32x4 g0 = {1.f, 1.f, 1.f, 1.f}, g1 = g0;
    if (t.gain) { const float* gp = (t.gainhi && k0 >= 1024) ? t.gainhi - 1024 : t.gain; g0 = *(const f32x4*)(gp + k0 + 8 * c); g1 = *(const f32x4*)(gp + k0 + 8 * c + 4); }
#pragma unroll
    for (int j = 0; j < 4; ++j) { const int n = (lane >> 3) + 8 * j; const LAS float* s = scr + (8 * c) * 33 + n;
        u32x4 o; o.x = pk_bf16(s[0 * 33] * g0.x, s[1 * 33] * g0.y); o.y = pk_bf16(s[2 * 33] * g0.z, s[3 * 33] * g0.w); o.z = pk_bf16(s[4 * 33] * g1.x, s[5 * 33] * g1.y); o.w = pk_bf16(s[6 * 33] * g1.z, s[7 * 33] * g1.w);
        bf16_t* dst = t.blocked ? t.WT + ((size_t)kb * t.N + d0 + n) * 64 + 8 * c : t.WT + (size_t)(d0 + n) * t.K + k0 + 8 * c;
        *(u32x4*)dst = o; }
    LDS_WAIT();
}
__device__ __forceinline__ void rms_row_to_bf16(const float* xrow, const float* gain, bf16_t* orow, int lane) {
    const f32x4* xr = (const f32x4*)xrow + lane; const f32x4* gr = (const f32x4*)gain + lane;
    f32x4 v[8]; float s = 0.f;
#pragma unroll
    for (int j = 0; j < 8; ++j) { v[j] = xr[64 * j]; s += (v[j].x * v[j].x + v[j].y * v[j].y) + (v[j].z * v[j].z + v[j].w * v[j].w); }
    const float rstd = rsqrtf(wave_sum(s) * (1.f / DM) + EPS);
    u32x2* o8 = (u32x2*)orow + lane;
#pragma unroll
    for (int j = 0; j < 8; ++j) { const f32x4 g = gr[64 * j]; u32x2 o; o.x = pk_bf16(v[j].x * rstd * g.x, v[j].y * rstd * g.y); o.y = pk_bf16(v[j].z * rstd * g.z, v[j].w * rstd * g.w); o8[64 * j] = o; }
}
__device__ __forceinline__ void rms_rows_phase(const float* src, const float* gain, bf16_t* dst, int rows, int gw, int ngw, int lane) {
    for (int r = gw; r < rows; r += ngw) rms_row_to_bf16(src + (size_t)r * DM, gain, dst + (size_t)r * DM, lane);
}

__device__ __forceinline__ bool tr_pick(const Params& p, int it, TrItem& t) {
    constexpr int I_IN = (DM / 64) * (2 * DFF / 32), I_OUT = (DFF / 64) * (DM / 32), I_MIXIN = (DM / 64) * (5120 / 32), I_SQ = (DM / 64) * (DM / 32), I_CKV = (DM / 64) * (4096 / 32);
    constexpr int NITEMS = 2 * I_IN + 2 * I_OUT + I_MIXIN + 2 * I_SQ + I_CKV;
    if (it >= NITEMS) return false;
    int r = it; t.gain = nullptr; t.gainhi = nullptr; t.mode = 0; t.blocked = 0;
    if (r < I_IN) { t.W = p.ffn1_w_in; t.WT = (bf16_t*)(p.ws + WS_WT_IN1); t.K = DM; t.N = 2 * DFF; t.mode = 1; t.gain = p.ffn1_norm; t.item = r; return true; } r -= I_IN;
    if (r < I_OUT) { t.W = p.ffn1_w_out; t.WT = (bf16_t*)(p.ws + WS_WT_OUT1); t.K = DFF; t.N = DM; t.blocked = 1; t.item = r; return true; } r -= I_OUT;
    if (r < I_MIXIN) { t.W = p.w_mix_in; t.WT = (bf16_t*)(p.ws + WS_WT_MIXIN); t.K = DM; t.N = 5120; t.gain = p.mix_norm; t.item = r; return true; } r -= I_MIXIN;
    if (r < I_SQ) { t.W = p.w_mix_out; t.WT = (bf16_t*)(p.ws + WS_WT_MIXOUT); t.K = DM; t.N = DM; t.gain = p.gnorm_a; t.gainhi = p.gnorm_b; t.item = r; return true; } r -= I_SQ;
    if (r < I_CKV) { t.W = p.w_ckv; t.WT = (bf16_t*)(p.ws + WS_WT_CKV); t.K = DM; t.N = 4096; t.item = r; return true; } r -= I_CKV;
    if (r < I_SQ) { t.W = p.w_co; t.WT = (bf16_t*)(p.ws + WS_WT_CO); t.K = DM; t.N = DM; t.item = r; return true; } r -= I_SQ;
    if (r < I_IN) { t.W = p.ffn2_w_in; t.WT = (bf16_t*)(p.ws + WS_WT_IN2); t.K = DM; t.N = 2 * DFF; t.mode = 1; t.gain = p.ffn2_norm; t.item = r; return true; } r -= I_IN;
    t.W = p.ffn2_w_out; t.WT = (bf16_t*)(p.ws + WS_WT_OUT2); t.K = DFF; t.N = DM; t.blocked = 1; t.item = r; return true;
}
__device__ __forceinline__ void phase_prologue(const Params& p, LAS unsigned char* lds, int gw, int ngw, int wave, int lane) {
    LAS float* scr = (LAS float*)(lds + wave * 16384);
    { float* ssz = (float*)(p.ws + WS_SS) + MTOK; for (int i = gw * 64 + lane; i < 6 * MTOK; i += ngw * 64) ssz[i] = 0.f; }
    TrItem cur, nxt; float r[32];
    bool have = tr_pick(p, gw, cur);
    if (have) tr_load(cur, r, lane);
    for (int it = gw; have; it += ngw) {
        const bool hn = tr_pick(p, it + ngw, nxt);
#pragma unroll
        for (int i = 0; i < 32; ++i) scr[(2 * i + (lane >> 5)) * 33 + (lane & 31)] = r[i];
        if (hn) tr_load(nxt, r, lane);
        tr_store(cur, scr, lane);
        cur = nxt; have = hn;
    }
    for (int r = gw; r < MTOK; r += ngw) {
        const f32x4* xr = (const f32x4*)(p.x + (size_t)r * DM) + lane; u32x2* o8 = (u32x2*)((bf16_t*)(p.ws + WS_HB) + (size_t)r * DM) + lane; float s = 0.f;
        f32x4 v[8];
#pragma unroll
        for (int j = 0; j < 8; ++j) { v[j] = xr[64 * j]; s += (v[j].x * v[j].x + v[j].y * v[j].y) + (v[j].z * v[j].z + v[j].w * v[j].w); }
#pragma unroll
        for (int j = 0; j < 8; ++j) { u32x2 o; o.x = pk_bf16(v[j].x, v[j].y); o.y = pk_bf16(v[j].z, v[j].w); o8[64 * j] = o; }
        s = wave_sum(s); if (lane == 0) ((float*)(p.ws + WS_SS))[r] = s;
    }
    rms_rows_phase(p.mem, p.mem_norm, (bf16_t*)(p.ws + WS_MEMN), MEMROWS, gw, ngw, lane);
    for (int r = gw; r < DM; r += ngw) {
        const f32x4* xr = (const f32x4*)(p.w_cq + (size_t)r * DM) + lane; u32x2* o8 = (u32x2*)((bf16_t*)(p.ws + WS_WT_CQ) + (size_t)r * DM) + lane; const float gk = p.cross_norm[r];
#pragma unroll
        for (int j = 0; j < 8; ++j) { const f32x4 v = xr[64 * j]; u32x2 o; o.x = pk_bf16(v.x * gk, v.y * gk); o.y = pk_bf16(v.z * gk, v.w * gk); o8[64 * j] = o; }
    }
}

__device__ __forceinline__ void phase_final_norm(const Params& p, int gw, int ngw, int lane) {
    const bf16_t* H = (const bf16_t*)(p.ws + WS_HB); const float* ss4 = (const float*)(p.ws + WS_SS) + 4 * MTOK;
    for (int r = gw; r < MTOK; r += ngw) {
        const u32x4* hr = (const u32x4*)(H + (size_t)r * DM) + lane; f32x4* orow = (f32x4*)(p.out + (size_t)r * DM);
        const float rs = rstd_of(ss4[r]);
#pragma unroll
        for (int j = 0; j < 4; ++j) { const u32x4 h = hr[64 * j]; const int c4 = (64 * j + lane) * 2; const f32x4 g0 = ((const f32x4*)p.final_norm)[c4], g1 = ((const f32x4*)p.final_norm)[c4 + 1];
            __builtin_nontemporal_store((f32x4){bf_lo(h.x) * rs * g0.x, bf_hi(h.x) * rs * g0.y, bf_lo(h.y) * rs * g0.z, bf_hi(h.y) * rs * g0.w}, orow + c4);
            __builtin_nontemporal_store((f32x4){bf_lo(h.z) * rs * g1.x, bf_hi(h.z) * rs * g1.y, bf_lo(h.w) * rs * g1.z, bf_hi(h.w) * rs * g1.w}, orow + c4 + 1); }
    }
}

__device__ __forceinline__ void phase_ynorm(const Params& p, int gw, int ngw, int lane) {
    bf16_t* Y = (bf16_t*)(p.ws + WS_XN);
    for (int r = gw; r < MTOK; r += ngw) {
        u32x4* yr = (u32x4*)(Y + (size_t)r * DM) + lane;
        u32x4 v[4]; float ss[2] = {0.f, 0.f};
#pragma unroll
        for (int j = 0; j < 4; ++j) { v[j] = yr[64 * j]; float s = 0.f;
#pragma unroll
            for (int e = 0; e < 4; ++e) { const float a = bf_lo(v[j][e]), b = bf_hi(v[j][e]); s += a * a + b * b; }
            ss[j >> 1] += s; }
        const float ra = rsqrtf(wave_sum(ss[0]) * (1.f / 1024) + EPS), rb = rsqrtf(wave_sum(ss[1]) * (1.f / 1024) + EPS);
#pragma unroll
        for (int j = 0; j < 4; ++j) { const float rs = (j < 2) ? ra : rb; const float* g = ((j < 2) ? p.gnorm_a : p.gnorm_b) + (j & 1) * 512 + lane * 8;
            const f32x4 g0 = *(const f32x4*)g, g1 = *(const f32x4*)(g + 4); u32x4 o;
            o.x = pk_bf16(bf_lo(v[j].x) * rs * g0.x, bf_hi(v[j].x) * rs * g0.y); o.y = pk_bf16(bf_lo(v[j].y) * rs * g0.z, bf_hi(v[j].y) * rs * g0.w);
            o.z = pk_bf16(bf_lo(v[j].z) * rs * g1.x, bf_hi(v[j].z) * rs * g1.y); o.w = pk_bf16(bf_lo(v[j].w) * rs * g1.z, bf_hi(v[j].w) * rs * g1.w);
            yr[64 * j] = o; }
    }
}

__device__ __forceinline__ void phase_sgu_mfma(const Params& p, LAS unsigned char* lds, int wave, int lane, int first, int stride) {
    constexpr int VS = 272;
    const bf16_t* za = (const bf16_t*)(p.ws + WS_ZA); bf16_t* Y = (bf16_t*)(p.ws + WS_XN);
    const int l32 = lane & 31, hh = lane >> 5, tt = wave >> 1, cpair = wave & 1;
    for (int item = first; item < NB * 16 * 8; item += stride) {
        const int g = item & 7, n = (item >> 3) & 15, b = item >> 7; const size_t row0 = (size_t)b * SEQ + n * 128;
        const int t = 32 * tt + l32;
        unsigned vv[16];
#pragma unroll
        for (int r = 0; r < 16; ++r) vv[r] = *(const unsigned*)(za + (row0 + wave + 8 * r) * 2048 + 1024 + g * 128 + 2 * lane);
        const float* wrow = p.spatial_w + ((size_t)g * 128 + t) * 128 + 8 * hh;
        f32x4 w0[8], w1[8];
#pragma unroll
        for (int ks = 0; ks < 8; ++ks) if (ks < 4 || tt >= 2) { w0[ks] = *(const f32x4*)(wrow + 16 * ks); w1[ks] = *(const f32x4*)(wrow + 16 * ks + 4); }
        u32x2 uu[2][4];
#pragma unroll
        for (int ci = 0; ci < 2; ++ci)
#pragma unroll
            for (int cg4 = 0; cg4 < 4; ++cg4) uu[ci][cg4] = *(const u32x2*)(za + (row0 + t) * 2048 + g * 128 + 32 * (2 * cpair + ci) + 8 * cg4 + 4 * hh);
        const float bias = p.spatial_b[g * 128 + t]; float sqa = 0.f;
        const float g0 = p.ln_v_gain[g * 128 + 2 * lane], g1 = p.ln_v_gain[g * 128 + 2 * lane + 1], b0 = p.ln_v_bias[g * 128 + 2 * lane], b1 = p.ln_v_bias[g * 128 + 2 * lane + 1];
#pragma unroll
        for (int r = 0; r < 16; ++r) { const int s = wave + 8 * r;
            const float a = bf_lo(vv[r]), c = bf_hi(vv[r]);
            const float mu = wave_sum(a + c) * (1.f / 128); const float da = a - mu, dc = c - mu;
            const float var = wave_sum(da * da + dc * dc) * (1.f / 128); const float rstd = rsqrtf(var + EPS);
            const unsigned o = pk_bf16(da * rstd * g0 + b0, dc * rstd * g1 + b1);
            *(LAS bf16_t*)(lds + (2 * lane) * VS + s * 2) = (bf16_t)(o & 0xffffu); *(LAS bf16_t*)(lds + (2 * lane + 1) * VS + s * 2) = (bf16_t)(o >> 16);
        }
        __syncthreads();
        f32x16 acc[2];
#pragma unroll
        for (int i = 0; i < 16; ++i) { acc[0][i] = 0.f; acc[1][i] = 0.f; }
#pragma unroll
        for (int ks = 0; ks < 8; ++ks) if (ks < 4 || tt >= 2) {
            u32x4 wb; wb.x = pk_bf16(w0[ks].x, w0[ks].y); wb.y = pk_bf16(w0[ks].z, w0[ks].w); wb.z = pk_bf16(w1[ks].x, w1[ks].y); wb.w = pk_bf16(w1[ks].z, w1[ks].w);
            const bf16x8 bfrag = __builtin_bit_cast(bf16x8, wb);
#pragma unroll
            for (int ci = 0; ci < 2; ++ci) { const bf16x8 a = *(const LAS bf16x8*)(lds + (32 * (2 * cpair + ci) + l32) * VS + (16 * ks + 8 * hh) * 2); acc[ci] = MFMA32(a, bfrag, acc[ci]); }
        }
#pragma unroll
        for (int ci = 0; ci < 2; ++ci)
#pragma unroll
            for (int cg4 = 0; cg4 < 4; ++cg4) { const int c = 32 * (2 * cpair + ci) + 8 * cg4 + 4 * hh; const size_t o = (row0 + t) * 2048 + g * 128 + c;
                const u32x2 u2 = uu[ci][cg4]; u32x2 r;
                r.x = pk_bf16(bf_lo(u2.x) * (acc[ci][4 * cg4] + bias), bf_hi(u2.x) * (acc[ci][4 * cg4 + 1] + bias));
                r.y = pk_bf16(bf_lo(u2.y) * (acc[ci][4 * cg4 + 2] + bias), bf_hi(u2.y) * (acc[ci][4 * cg4 + 3] + bias));
                *(u32x2*)(Y + o) = r;
                sqa += (bf_lo(r.x) * bf_lo(r.x) + bf_hi(r.x) * bf_hi(r.x)) + (bf_lo(r.y) * bf_lo(r.y) + bf_hi(r.y) * bf_hi(r.y)); }
        sqa += __shfl_xor(sqa, 32); if (hh == 0) atomicAdd((float*)(p.ws + WS_SS) + 5 * MTOK + row0 + t, sqa);
        __syncthreads();
    }
}
__device__ __forceinline__ void phase_stick_mfma(const Params& p, LAS unsigned char* lds, int wave, int lane) {
    constexpr int KSTR = 272, VSTR = 136, KBYTES = 64 * KSTR, BUFB = KBYTES + 128 * VSTR;
    const bf16_t* qb = (const bf16_t*)(p.ws + WS_QB); const bf16_t* kb = (const bf16_t*)(p.ws + WS_KB); const bf16_t* vT = (const bf16_t*)(p.ws + WS_VT);
    bf16_t* Y = (bf16_t*)(p.ws + WS_XN);
    const int tid = opaque_tid(), l32 = lane & 31, hh = lane >> 5;
    for (int item = blockIdx.x; item < 256; item += gridDim.x) {
        const int pr = item & 3, head = (item >> 2) & 7, b = item >> 5;
        const bf16_t* kbase = kb + (size_t)b * SEQ * 1024 + head * 128;
        const bf16_t* vbase = vT + (size_t)(head * 128) * MTOK + (size_t)b * SEQ;
        for (int pass = 0; pass < 2; ++pass) {
            const int I = pass ? pr : 7 - pr;
            const int tw = 256 * I + 32 * wave;
            bf16x8 qf[8];
            { const bf16_t* qrow = qb + ((size_t)b * SEQ + tw + l32) * 1024 + head * 128 + 8 * hh;
#pragma unroll
              for (int kd = 0; kd < 8; ++kd) qf[kd] = *(const bf16x8*)(qrow + 16 * kd); }
            f32x16 oacc[4];
#pragma unroll
            for (int dt = 0; dt < 4; ++dt)
#pragma unroll
                for (int i = 0; i < 16; ++i) oacc[dt][i] = 0.f;
            float R = 0.f;
            const int jmax = 4 * I + 3;
            u32x4 kr[2], vr[2];
            unsigned koff[2], voff[2];
#pragma unroll
            for (int i_ = 0; i_ < 2; ++i_) { const int c_ = tid + 512 * i_; koff[i_] = (unsigned)(((64 * jmax + (c_ >> 4)) * 1024 + (c_ & 15) * 8) * 2); voff[i_] = (unsigned)((c_ >> 3) * (MTOK * 2) + (64 * jmax + (c_ & 7) * 8) * 2); }
#define STK_LOAD() do { _Pragma("unroll") for (int i_ = 0; i_ < 2; ++i_) { kr[i_] = *(const u32x4*)((const char*)kbase + koff[i_]); vr[i_] = *(const u32x4*)((const char*)vbase + voff[i_]); koff[i_] -= 64 * 1024 * 2; voff[i_] -= 128; } } while (0)
            STK_LOAD();
            for (int j = jmax; j >= 0; --j) {
                LAS unsigned char* bufp = lds + (j & 1) * BUFB;
#pragma unroll
                for (int i_ = 0; i_ < 2; ++i_) { const int c_ = tid + 512 * i_;
                    *(LAS u32x4*)(bufp + (c_ >> 4) * KSTR + (c_ & 15) * 16) = kr[i_];
                    LAS u32x2* vp = (LAS u32x2*)(bufp + KBYTES + (c_ >> 3) * VSTR + (c_ & 7) * 16); vp[0] = (u32x2){vr[i_].x, vr[i_].y}; vp[1] = (u32x2){vr[i_].z, vr[i_].w}; }
                const bool alive = __builtin_amdgcn_ballot_w64(R >= -160.f) != 0ull;
                if (lane == 0) *(volatile LAS unsigned*)(lds + 2 * BUFB + ((j & 1) * 8 + wave) * 4) = alive ? 1u : 0u;
                __syncthreads();
                { const u32x4 f0 = *(const LAS u32x4*)(lds + 2 * BUFB + (j & 1) * 32), f1 = *(const LAS u32x4*)(lds + 2 * BUFB + (j & 1) * 32 + 16);
                  if (((f0.x | f0.y) | (f0.z | f0.w) | (f1.x | f1.y) | (f1.z | f1.w)) == 0u) break; }
                if (j > 0) STK_LOAD();
                const int k0 = 64 * j;
                if (alive && k0 <= tw + 30) {
                    const bool diag = (k0 + 63 >= tw); const int t = tw + l32;
                    float run = R;
#pragma unroll
                    for (int ks = 1; ks >= 0; --ks) {
                        f32x16 s, lm;
#pragma unroll
                        for (int i = 0; i < 16; ++i) s[i] = 0.f;
#pragma unroll
                        for (int kd = 0; kd < 8; ++kd) { const bf16x8 a = *(const LAS bf16x8*)(bufp + (32 * ks + l32) * KSTR + (16 * kd + 8 * hh) * 2); s = MFMA32(a, qf[kd], s); }
                        if (diag) {
#pragma unroll
                            for (int i = 0; i < 16; ++i) { const int key = k0 + 32 * ks + 8 * (i >> 2) + 4 * hh + (i & 3); if (key >= t) s[i] = -1.0e30f; } }
#pragma unroll
                        for (int i = 0; i < 16; ++i) { const float z = s[i]; const float e = __builtin_amdgcn_exp2f(-fabsf(z)); lm[i] = -(fmaxf(z, 0.f) + __builtin_amdgcn_logf(1.f + e)); }
                        float gs[4], og[4];
#pragma unroll
                        for (int c4 = 0; c4 < 4; ++c4) { gs[c4] = (lm[4 * c4] + lm[4 * c4 + 1]) + (lm[4 * c4 + 2] + lm[4 * c4 + 3]); og[c4] = __shfl_xor(gs[c4], 32); }
#pragma unroll
                        for (int c4 = 3; c4 >= 0; --c4) {
                            const float r3 = run + (hh == 0 ? og[c4] : 0.f);
                            const float r2 = r3 + lm[4 * c4 + 3], r1 = r2 + lm[4 * c4 + 2], r0 = r1 + lm[4 * c4 + 1];
                            s[4 * c4 + 3] = __builtin_amdgcn_exp2f(s[4 * c4 + 3] + lm[4 * c4 + 3] + r3);
                            s[4 * c4 + 2] = __builtin_amdgcn_exp2f(s[4 * c4 + 2] + lm[4 * c4 + 2] + r2);
                            s[4 * c4 + 1] = __builtin_amdgcn_exp2f(s[4 * c4 + 1] + lm[4 * c4 + 1] + r1);
                            s[4 * c4] = __builtin_amdgcn_exp2f(s[4 * c4] + lm[4 * c4] + r0);
                            run += gs[c4] + og[c4]; }
#pragma unroll
                        for (int kk = 0; kk < 2; ++kk) {
                            u32x4 pw; pw.x = pk_bf16(s[8 * kk], s[8 * kk + 1]); pw.y = pk_bf16(s[8 * kk + 2], s[8 * kk + 3]); pw.z = pk_bf16(s[8 * kk + 4], s[8 * kk + 5]); pw.w = pk_bf16(s[8 * kk + 6], s[8 * kk + 7]);
                            const bf16x8 pf = __builtin_bit_cast(bf16x8, pw);
#pragma unroll
                            for (int dt = 0; dt < 4; ++dt) { const LAS unsigned char* va = bufp + KBYTES + (32 * dt + l32) * VSTR + (32 * ks + 16 * kk + 4 * hh) * 2;
                                const u32x2 v0 = *(const LAS u32x2*)va, v1 = *(const LAS u32x2*)(va + 16);
                                const u32x4 vw = {v0.x, v0.y, v1.x, v1.y};
                                oacc[dt] = MFMA32(__builtin_bit_cast(bf16x8, vw), pf, oacc[dt]); } }
                    }
                    R = run;
                }
            }
#undef STK_LOAD
            __syncthreads();
            bf16_t* yrow = Y + ((size_t)b * SEQ + tw + l32) * 2048 + 1024 + head * 128 + 4 * hh; float sqb = 0.f;
#pragma unroll
            for (int dt = 0; dt < 4; ++dt)
#pragma unroll
                for (int c4 = 0; c4 < 4; ++c4) { u32x2 r; r.x = pk_bf16(oacc[dt][4 * c4], oacc[dt][4 * c4 + 1]); r.y = pk_bf16(oacc[dt][4 * c4 + 2], oacc[dt][4 * c4 + 3]); *(u32x2*)(yrow + 32 * dt + 8 * c4) = r;
                    sqb += (bf_lo(r.x) * bf_lo(r.x) + bf_hi(r.x) * bf_hi(r.x)) + (bf_lo(r.y) * bf_lo(r.y) + bf_hi(r.y) * bf_hi(r.y)); }
            sqb += __shfl_xor(sqb, 32); if (hh == 0) atomicAdd((float*)(p.ws + WS_SS) + 6 * MTOK + (size_t)b * SEQ + tw + l32, sqb);
        }
    }
}

#define XB_TMO      128
#define XB_XCNT(j)  (256  + 64 * (j))
#define XB_XSUB(j)  (1280 + 64 * (j))
#define XB_XGEN(j)  (2304 + 64 * (j))
#define XB_TOP      3328
#define XB_TOPGEN   3392
#define XCD_BAR_WORDS 3456
#define XB_SPIN_CAP (1u << 20)
__device__ __forceinline__ unsigned xb_ld(unsigned* p)              { return __hip_atomic_load(p, __ATOMIC_RELAXED, __HIP_MEMORY_SCOPE_AGENT); }
__device__ __forceinline__ unsigned xb_add(unsigned* p, unsigned v) { return __hip_atomic_fetch_add(p, v, __ATOMIC_RELAXED, __HIP_MEMORY_SCOPE_AGENT); }
__device__ __forceinline__ unsigned xb_xcc_id() { return (unsigned)__builtin_amdgcn_s_getreg((3 << 11) | 20) & 0xFu; }
#define XB_SPIN(cond, bar) do { unsigned _sp = 0; while (cond) { __builtin_amdgcn_s_sleep(1); \
    if ((++_sp & 255u) == 0u) { if (xb_ld(&(bar)[XB_TMO])) break; if (_sp > XB_SPIN_CAP) { atomicAdd(&(bar)[XB_TMO], 1u); break; } } } } while (0)
__device__ __forceinline__ void xcd_barrier_post(unsigned* bar) { if (threadIdx.x == 0) (void)xb_add(&bar[XB_XCNT(xb_xcc_id())], 1u); }
__device__ __forceinline__ void xcd_barrier_complete(unsigned* bar, unsigned x, unsigned& nloc, unsigned& nx) {
    const unsigned G = gridDim.x * gridDim.y * gridDim.z;
    unsigned sum, cnt, mine, sp = 0u;
    for (;;) {
        sum = 0u; cnt = 0u; mine = 0u;
#pragma unroll
        for (unsigned j = 0; j < 16; ++j) { const unsigned c = xb_ld(&bar[XB_XCNT(j)]); sum += c; cnt += (c > 0u) ? 1u : 0u; mine = (j == x) ? c : mine; }
        if (sum == G) break;
        __builtin_amdgcn_s_sleep(1);
        if ((++sp & 255u) == 0u) { if (xb_ld(&bar[XB_TMO])) break; if (sp > XB_SPIN_CAP) { atomicAdd(&bar[XB_TMO], 1u); break; } }
    }
    nloc = mine > 0u ? mine : 1u; nx = cnt > 0u ? cnt : 1u;
}
__device__ __forceinline__ void xcd_barrier(unsigned* bar, volatile LAS unsigned* st) {
    asm volatile("s_waitcnt vmcnt(0)" ::: "memory");
    __syncthreads();
    if (threadIdx.x == 0) {
        const unsigned x = xb_xcc_id();
        __builtin_amdgcn_s_waitcnt(0);
        unsigned nloc = st[0], nx = st[1];
        if (nloc == 0u) { xcd_barrier_complete(bar, x, nloc, nx); st[0] = nloc; st[1] = nx; }
        const unsigned old = xb_add(&bar[XB_XSUB(x)], 1u);
        const unsigned gen = old / nloc;
        if (old + 1u == (gen + 1u) * nloc) {
            __builtin_amdgcn_fence(__ATOMIC_RELEASE, "agent");
            asm volatile("s_waitcnt vmcnt(0)" ::: "memory");
            const unsigned og = xb_add(&bar[XB_TOP], 1u);
            const unsigned tg = og / nx;
            if (og + 1u == (tg + 1u) * nx) xb_add(&bar[XB_TOPGEN], 1u);
            else XB_SPIN(xb_ld(&bar[XB_TOPGEN]) == tg, bar);
            __builtin_amdgcn_fence(__ATOMIC_ACQUIRE, "agent");
            xb_add(&bar[XB_XGEN(x)], 1u);
            asm volatile("s_waitcnt vmcnt(0)" ::: "memory");
        } else {
            XB_SPIN(xb_ld(&bar[XB_XGEN(x)]) == gen, bar);
            __builtin_amdgcn_fence(__ATOMIC_ACQUIRE, "agent");
            asm volatile("s_waitcnt vmcnt(0)" ::: "memory");
        }
    }
    __syncthreads();
}

constexpr int NPHASES = 12;
constexpr int LDS_BYTES = 144 * 1024;

__global__ __launch_bounds__(512, 2) void mega(Params p) {
    extern __shared__ __attribute__((aligned(16))) unsigned char shm[];
    LAS unsigned char* lds = (LAS unsigned char*)shm;
    cg::grid_group grid = cg::this_grid();
    const int ngw = gridDim.x * 8;
    unsigned* const xbar = (unsigned*)(p.ws + WS_BAR);
    volatile LAS unsigned* const xst = (volatile LAS unsigned*)(lds + LDS_BYTES - 16);
    if (threadIdx.x == 0) { xst[0] = 0u; xst[1] = 0u; }
    __syncthreads();
    xcd_barrier_post(xbar);
    const int G = gridDim.x, c = blockIdx.x;
    unsigned char* ws = p.ws;
#define PH_BEGIN(n) if (p.ph_lo <= (n) && (n) < p.ph_hi) { const int tid_ = opaque_tid(); const int wave = tid_ >> 6, lane = tid_ & 63, gw = blockIdx.x * 8 + wave; (void)gw; (void)lane;
#define PH_END(n) } if (p.ph_lo <= (n) && (n) + 1 < p.ph_hi) { if (p.ph_hi > NPHASES) grid.sync(); else xcd_barrier(xbar, xst); }
#define GEMM_SWIGLU(AOFF, WOFF, SSP) { pg8::MultiOrder<1> S; S.s[0] = {(const bf16_t*)(ws + (AOFF)), (const bf16_t*)(ws + (WOFF)), 64, 44}; S.G = G; S.c = c; S.lda = DM; S.ldb = DM; \
        LAS float* tab = (LAS float*)(lds + pg8::STAGE_BYTES); \
        for (int e_ = tid_; e_ < 11 * 256; e_ += 512) { pg8::Unit u_; if (S.next(e_ >> 8, u_)) tab[e_] = rstd_of((SSP)[u_.pm * 256 + (e_ & 255)]); } __syncthreads(); \
        pg8::EpiSwiglu E{(bf16_t*)(ws + WS_ACT), tab}; pg8::gemm_phase(lds, DM, S, E); }
#define GEMM_RESID(MK, AOFF, WOFF, KK, ALPHA, SSP) { pg8::MultiOrder<1> S; S.s[0] = {(const bf16_t*)(ws + (AOFF)), (const bf16_t*)(ws + (WOFF)), 64, 8}; S.G = G; S.c = c; S.lda = (KK); S.ldb = (KK); \
        LAS float* tab = (LAS float*)(lds + pg8::STAGE_BYTES); \
        if (MK > 0) { const int rnd = tid_ >> 8, rl = tid_ & 255; pg8::Unit u_; if (S.next(rnd, u_)) { const int row = u_.pm * 256 + rl; \
            const float ra = rsqrtf(ss0[5 * MTOK + row] * (1.f / 1024) + EPS), rb = rsqrtf(ss0[6 * MTOK + row] * (1.f / 1024) + EPS); tab[rnd * 512 + rl] = ra / rb; tab[rnd * 512 + 256 + rl] = rb; } __syncthreads(); } \
        pg8::EpiResid<MK> E{(bf16_t*)(ws + WS_HB), (SSP), tab, (ALPHA)}; pg8::gemm_phase(lds, (KK), S, E); }
#define GEMM_FFN_OUT(WOFF, ALPHA, SSP) { pg8::MultiOrder<1, (size_t)MTOK * 128, (size_t)DM * 128> S; S.s[0] = {(const bf16_t*)(ws + WS_ACT), (const bf16_t*)(ws + (WOFF)), 64, 8}; S.G = G; S.c = c; S.lda = 64; S.ldb = 64; \
        pg8::EpiResid<0> E{(bf16_t*)(ws + WS_HB), (SSP), (LAS float*)(lds + pg8::STAGE_BYTES), (ALPHA)}; pg8::gemm_phase(lds, DFF, S, E); }
    float* const ss0 = (float*)(ws + WS_SS); float* const ss1 = ss0 + MTOK; float* const ss2 = ss1 + MTOK; float* const ss3 = ss2 + MTOK; float* const ss4 = ss3 + MTOK;
    PH_BEGIN(0) phase_prologue(p, lds, gw, ngw, wave, lane); PH_END(0)
#ifdef PROBE_DUP0
    PH_BEGIN(0) phase_prologue(p, lds, gw, ngw, wave, lane); PH_END(0)
#endif
    PH_BEGIN(1) GEMM_SWIGLU(WS_HB, WS_WT_IN1, ss0) PH_END(1)
    PH_BEGIN(2) GEMM_FFN_OUT(WS_WT_OUT1, 0.5f, ss1) PH_END(2)
    PH_BEGIN(3) {
        pg8::MultiOrder<2> S; const bf16_t* hn = (const bf16_t*)(ws + WS_HB); const bf16_t* wm = (const bf16_t*)(ws + WS_WT_MIXIN);
        S.s[0] = {hn, wm, 64, 16}; S.s[1] = {wm + (size_t)4096 * DM, hn, 4, 64};
        S.G = G; S.c = c; S.lda = DM; S.ldb = DM;
        LAS float* tab = (LAS float*)(lds + pg8::STAGE_BYTES);
        for (int e_ = tid_; e_ < 5 * 256; e_ += 512) { pg8::Unit u_; if (S.next(e_ >> 8, u_)) tab[e_] = rstd_of(ss1[(u_.sub == 0 ? u_.pm : u_.pn) * 256 + (e_ & 255)]); }
        __syncthreads();
        pg8::EpiMixIn E{ws, tab};
        pg8::gemm_phase(lds, DM, S, E); } PH_END(3)
    PH_BEGIN(4) {
        phase_stick_mfma(p, lds, wave, lane); __syncthreads();
        const int ng = G >> 1;
        if (c < ng) {
            pg8::MultiOrder<4> S; const bf16_t* mn = (const bf16_t*)(ws + WS_MEMN); const bf16_t* wkv = (const bf16_t*)(ws + WS_WT_CKV);
            S.s[0] = {mn, wkv, 0, 8}; S.s[1] = {mn, wkv, 0, 8}; S.s[2] = {mn, wkv, 8, 16}; S.s[3] = {mn, wkv, 0, 8};
            S.G = ng; S.c = c; S.lda = DM; S.ldb = DM;
            pg8::EpiMixIn E{ws, (LAS float*)(lds + pg8::STAGE_BYTES)};
            pg8::gemm_phase(lds, DM, S, E);
        } else phase_sgu_mfma(p, lds, wave, lane, c - ng, G - ng); } PH_END(4)
    PH_BEGIN(5) GEMM_RESID(16, WS_XN, WS_WT_MIXOUT, DM, 1.f, ss2) PH_END(5)
    PH_BEGIN(6) {
        pg8::CrossPrepOrder S{(const bf16_t*)(ws + WS_KV), (const bf16_t*)(ws + WS_VTX), (const bf16_t*)(ws + WS_WT_CQ), (const bf16_t*)(ws + WS_WT_CO), G, c, (size_t)DM, (size_t)DM};
        pg8::EpiCrossPrep E{(bf16_t*)(ws + WS_MT), (bf16_t*)(ws + WS_VWT)};
        pg8::gemm_phase(lds, 512, S, E); } PH_END(6)
    PH_BEGIN(7) {
        pg8::CrossSOrder S{(const bf16_t*)(ws + WS_HB), (const bf16_t*)(ws + WS_MT), G, c, (size_t)DM, (size_t)DM};
        LAS float* rtab = (LAS float*)(lds + pg8::STAGE_BYTES + 8192);
        { const int rnd = tid_ >> 8; pg8::Unit u_; if (S.next(rnd, u_)) rtab[tid_] = rstd_of(ss2[u_.pm * 256 + (tid_ & 255)]); }
        __syncthreads();
        pg8::EpiSoftmax E{(bf16_t*)(ws + WS_P), (LAS float*)(lds + pg8::STAGE_BYTES), rtab, 0.04419417382415922f * 1.4426950408889634f};
        pg8::gemm_phase(lds, DM, S, E); } PH_END(7)
    PH_BEGIN(8) {
        pg8::CrossOutOrder S{(const bf16_t*)(ws + WS_P), (const bf16_t*)(ws + WS_VWT), G, c, (size_t)1024, (size_t)1024};
        pg8::EpiResid<0> E{(bf16_t*)(ws + WS_HB), ss3, (LAS float*)(lds + pg8::STAGE_BYTES), 1.f};
        pg8::gemm_phase(lds, 1024, S, E); } PH_END(8)
    PH_BEGIN(9) GEMM_SWIGLU(WS_HB, WS_WT_IN2, ss3) PH_END(9)
    PH_BEGIN(10) GEMM_FFN_OUT(WS_WT_OUT2, 0.5f, ss4) PH_END(10)
    PH_BEGIN(11) phase_final_norm(p, gw, ngw, lane); PH_END(11)
}

extern "C" void kernel_launch(void* const* d_in, const int* in_sizes, int n_in, void* d_out, int out_size, void* d_ws, size_t ws_size, hipStream_t stream) {
    static int grid = 0;
    if (grid == 0) {
        if (n_in != 23 || out_size != MTOK * DM || ws_size < WS_END) { fprintf(stderr, "kernel_launch: unexpected problem (n_in %d out %d ws %zu, need %zu)\n", n_in, out_size, ws_size, (size_t)WS_END); grid = -1; return; }
        int dev = 0, cus = 0, per_cu = 0;
        hipGetDevice(&dev); hipDeviceGetAttribute(&cus, hipDeviceAttributeMultiprocessorCount, dev);
        if (hipFuncSetAttribute((const void*)mega, hipFuncAttributeMaxDynamicSharedMemorySize, LDS_BYTES) != hipSuccess) { fprintf(stderr, "kernel_launch: hipFuncSetAttribute failed\n"); grid = -1; return; }
        if (hipOccupancyMaxActiveBlocksPerMultiprocessor(&per_cu, (const void*)mega, 512, LDS_BYTES) != hipSuccess || per_cu < 1) { fprintf(stderr, "kernel_launch: occupancy query says %d\n", per_cu); per_cu = 1; }
        (void)hipGetLastError();
        grid = cus * per_cu;
    }
    if (grid < 0) return;
    Params p{};
    const float** pp = (const float**)&p;
    for (int i = 0; i < 23; ++i) pp[i] = (const float*)d_in[i];
    p.out = (float*)d_out; p.ws = (unsigned char*)d_ws; p.ph_lo = 0; p.ph_hi = NPHASES;
    if (hipMemsetAsync((unsigned char*)d_ws + WS_BAR, 0, 3456 * 4, stream) != hipSuccess) { fprintf(stderr, "kernel_launch: memset of the barrier words failed\n"); return; }
    void* args[] = {&p};
    hipError_t e = hipLaunchCooperativeKernel((const void*)mega, dim3(grid), dim3(512), args, LDS_BYTES, stream);
    if (e != hipSuccess) fprintf(stderr, "kernel_launch: cooperative launch failed: %s (grid %d)\n", hipGetErrorString(e), grid);
}
```

```cpp
#include <hip/hip_runtime.h>
#include <hip/hip_cooperative_groups.h>
#include <cstdio>
namespace cg = cooperative_groups;

#define LAS __attribute__((address_space(3)))
typedef unsigned short bf16_t;
typedef short bf16x8 __attribute__((ext_vector_type(8)));
typedef float f32x4 __attribute__((ext_vector_type(4)));
typedef float f32x2 __attribute__((ext_vector_type(2)));
typedef unsigned u32x4 __attribute__((ext_vector_type(4)));
typedef unsigned u32x2 __attribute__((ext_vector_type(2)));

constexpr int MTOK = 16384, DM = 2048, DFF = 5632, SEQ = 2048, NB = 8, NMEM = 256, MEMROWS = NB * NMEM;
constexpr float EPS = 1e-6f;
constexpr size_t MiB = 1024 * 1024;
constexpr size_t WS_WT_IN1 = 0;
constexpr size_t WS_WT_OUT1 = WS_WT_IN1 + 44 * MiB;
constexpr size_t WS_WT_MIXIN = WS_WT_OUT1 + 22 * MiB;
constexpr size_t WS_WT_MIXOUT = WS_WT_MIXIN + 20 * MiB;
constexpr size_t WS_WT_CQ = WS_WT_MIXOUT + 8 * MiB;
constexpr size_t WS_WT_CKV = WS_WT_CQ + 8 * MiB;
constexpr size_t WS_WT_CO = WS_WT_CKV + 16 * MiB;
constexpr size_t WS_WT_IN2 = WS_WT_CO + 8 * MiB;
constexpr size_t WS_WT_OUT2 = WS_WT_IN2 + 44 * MiB;
constexpr size_t WS_XN = WS_WT_OUT2 + 22 * MiB;
constexpr size_t WS_HB = WS_XN + 64 * MiB;
constexpr size_t WS_ACT = WS_HB + 64 * MiB;
constexpr size_t WS_ZA = WS_ACT;
constexpr size_t WS_QB = WS_ZA + 64 * MiB;
constexpr size_t WS_KB = WS_QB + 32 * MiB;
constexpr size_t WS_VT = WS_KB + 32 * MiB;
constexpr size_t WS_MT = WS_ACT;
constexpr size_t WS_VWT = WS_MT + 32 * MiB;
constexpr size_t WS_P = WS_VWT + 32 * MiB;
constexpr size_t WS_MEMN = WS_ACT + 176 * MiB;
constexpr size_t WS_KV = WS_MEMN + 8 * MiB;
constexpr size_t WS_VTX = WS_KV + 8 * MiB;
constexpr size_t WS_SS = WS_VTX + 8 * MiB;
constexpr size_t WS_BAR = WS_SS + 512 * 1024;
constexpr size_t WS_END = WS_SS + 1 * MiB;

struct Params {
    const float* x; const float* mem; const float* ffn1_norm; const float* ffn1_w_in; const float* ffn1_w_out; const float* mix_norm; const float* w_mix_in;
    const float* ln_v_gain; const float* ln_v_bias; const float* spatial_w; const float* spatial_b; const float* gnorm_a; const float* gnorm_b; const float* w_mix_out;
    const float* cross_norm; const float* mem_norm; const float* w_cq; const float* w_ckv; const float* w_co; const float* ffn2_norm; const float* ffn2_w_in;
    const float* ffn2_w_out; const float* final_norm;
    float* out; unsigned char* ws; int ph_lo, ph_hi;
};

typedef __bf16 bf16x2_t __attribute__((ext_vector_type(2)));
typedef float f32x16 __attribute__((ext_vector_type(16)));
__device__ __forceinline__ unsigned pk_bf16(float lo, float hi) { f32x2 v = {lo, hi}; bf16x2_t r = __builtin_convertvector(v, bf16x2_t); return __builtin_bit_cast(unsigned, r); }
#define MFMA32(a, b, c) __builtin_amdgcn_mfma_f32_32x32x16_bf16((a), (b), (c), 0, 0, 0)
__device__ __forceinline__ float bf_lo(unsigned u) { return __uint_as_float(u << 16); }
__device__ __forceinline__ float bf_hi(unsigned u) { return __uint_as_float(u & 0xffff0000u); }
__device__ __forceinline__ float wave_sum(float v) {
#pragma unroll
    for (int o = 1; o < 64; o <<= 1) v += __shfl_xor(v, o);
    return v;
}
__device__ __forceinline__ float wave_max(float v) {
#pragma unroll
    for (int o = 1; o < 64; o <<= 1) v = fmaxf(v, __shfl_xor(v, o));
    return v;
}
__device__ __forceinline__ float gelu_tanh(float x) { const float u2 = -2.302208198f * (x + 0.044715f * x * x * x); return x * __builtin_amdgcn_rcpf(1.f + __builtin_amdgcn_exp2f(u2)); }
__device__ __forceinline__ float silu(float g) { return g * __builtin_amdgcn_rcpf(1.f + __builtin_amdgcn_exp2f(-1.4426950408889634f * g)); }
__device__ __forceinline__ float rstd_of(float ss) { return rsqrtf(ss * (1.f / DM) + EPS); }
__device__ __forceinline__ int opaque_tid() { int t = threadIdx.x; asm volatile("" : "+v"(t)); return t; }
#define LDS_WAIT() asm volatile("s_waitcnt lgkmcnt(0)" ::: "memory")

namespace pg8 {
constexpr int BM = 256, BK = 64, HALF = 128, HTB = HALF * BK * 2, STAGE_BYTES = 8 * HTB, NXCD = 8, WGM = 8;
__device__ __forceinline__ int lds_byte(int r, int c) { const int st = (r >> 4) * 2 + (c >> 5), rr = r & 15, cc = c & 31, ob = rr * 64 + cc * 2; return st * 1024 + (ob ^ (((ob >> 9) & 1) << 5)); }
__device__ __forceinline__ void stage_rc(int b, int& R, int& C) { const int st = b / 1024, sb = b % 1024, swz = sb ^ (((sb >> 9) & 1) << 5); R = (st >> 1) * 16 + swz / 64; C = (st & 1) * 32 + (swz % 64) / 2; }
__device__ __forceinline__ int perm32(int rho) { const int n = rho >> 4, i = rho & 15; return 8 * (i >> 2) + 4 * n + (i & 3); }

struct Unit { const char* A; const char* B; int pm, pn, sub, round, aux; };
struct SubG { const bf16_t* A; const bf16_t* B; int nM, nN; };

template <int NS, size_t KSA_ = 128, size_t KSB_ = 128> struct MultiOrder {
    static constexpr size_t KSA = KSA_, KSB = KSB_;
    SubG s[NS]; int G, c; size_t lda, ldb;
    __device__ __forceinline__ bool next(int i, Unit& u) const {
        long L = (long)i * G + c;
#pragma unroll
        for (int j = 0; j < NS; ++j) {
            const int nM = s[j].nM, nN = s[j].nN, nwg = nM * nN;
            if (L < nwg) {
                int wgid = (int)L; { const int q = nwg / NXCD, r = nwg % NXCD, xcd = wgid % NXCD, off = wgid / NXCD; wgid = (xcd < r ? xcd * (q + 1) : r * (q + 1) + (xcd - r) * q) + off; }
                const int nig = WGM * nN, gid = wgid / nig, fm = gid * WGM, gsz = (nM - fm) < WGM ? (nM - fm) : WGM;
                u.pm = fm + ((wgid % nig) % gsz); u.pn = (wgid % nig) / gsz; u.sub = j; u.round = i; u.aux = 0;
                u.A = (const char*)s[j].A + (size_t)u.pm * 256 * lda * 2; u.B = (const char*)s[j].B + (size_t)u.pn * 256 * ldb * 2;
                return true;
            }
            L -= nwg;
        }
        return false;
    }
};

#ifndef PG8_SP2
#define PG8_SP2 true
#endif
#ifndef PG8_ALIGN
#define PG8_ALIGN true
#endif
template <class Epi, class Sched, bool ALIGN_EPI = PG8_ALIGN, bool SP2 = PG8_SP2>
__device__ __forceinline__ void gemm_phase(LAS unsigned char* lds, const int K, const Sched S, const Epi E) {
    const int tid = opaque_tid(), wid = __builtin_amdgcn_readfirstlane(tid >> 6), lane = tid & 63, wr = wid >> 2, wc = wid & 3, fr = lane & 15, fq = lane >> 4;
    const int nt = K / BK;
    const int lda = (int)S.lda, ldb = (int)S.ldb;
    unsigned voffA[2], voffB[2];
#pragma unroll
    for (int i = 0; i < 2; ++i) { int R, C; stage_rc(tid * 16 + i * 8192, R, C); const int Rb = Epi::PERM ? ((R & ~31) + perm32(R & 31)) : R;
        voffA[i] = (unsigned)(R * lda + C) * 2u; voffB[i] = (unsigned)(Rb * ldb + C) * 2u; }
    constexpr size_t kstepA = Sched::KSA, kstepB = Sched::KSB;
    const size_t hstepA = (size_t)HALF * lda * 2, hstepB = (size_t)HALF * ldb * 2;
    const unsigned ldsw = (unsigned)wid * 1024u;
    const int aoff = lds_byte(wr * 64 + fr, fq * 8), boff = lds_byte(wc * 32 + fr, fq * 8);
#define PG8_SA(b, h) (((b) * 2 + (h)) * HTB)
#define PG8_SB(b, h) ((4 + (b) * 2 + (h)) * HTB)
#define PG8_STAGE(bufoff, gbase, voff) do { _Pragma("unroll") for (int _i = 0; _i < 2; ++_i) \
        __builtin_amdgcn_global_load_lds((const unsigned*)((const char*)(gbase) + (voff)[_i]), (LAS unsigned*)(lds + (bufoff) + ldsw + _i * 8192), 16, 0, 0); } while (0)
#define PG8_LDA(dst, b, h) do { _Pragma("unroll") for (int m = 0; m < 4; ++m) _Pragma("unroll") for (int k = 0; k < 2; ++k) dst[m][k] = *(const LAS bf16x8*)(lds + PG8_SA(b, h) + aoff + m * 2048 + k * 1024); } while (0)
#define PG8_LDB(dst, b, h) do { _Pragma("unroll") for (int n = 0; n < 2; ++n) _Pragma("unroll") for (int k = 0; k < 2; ++k) dst[n][k] = *(const LAS bf16x8*)(lds + PG8_SB(b, h) + boff + n * 2048 + k * 1024); } while (0)
#define PG8_MMA(ai, bj, At, Bt) do { __builtin_amdgcn_s_setprio(1); _Pragma("unroll") for (int m = 0; m < 4; ++m) _Pragma("unroll") for (int n = 0; n < 2; ++n) _Pragma("unroll") for (int k = 0; k < 2; ++k) \
        acc[ai][bj][m][n] = __builtin_amdgcn_mfma_f32_16x16x32_bf16(Bt[n][k], At[m][k], acc[ai][bj][m][n], 0, 0, 0); __builtin_amdgcn_s_setprio(0); } while (0)
#define PG8_MMA2(ai, bj, At, Bt, ai2, bj2, At2, Bt2) do { __builtin_amdgcn_s_setprio(1); _Pragma("unroll") for (int m = 0; m < 4; ++m) _Pragma("unroll") for (int n = 0; n < 2; ++n) _Pragma("unroll") for (int k = 0; k < 2; ++k) \
        acc[ai][bj][m][n] = __builtin_amdgcn_mfma_f32_16x16x32_bf16(Bt[n][k], At[m][k], acc[ai][bj][m][n], 0, 0, 0); \
        _Pragma("unroll") for (int m = 0; m < 4; ++m) _Pragma("unroll") for (int n = 0; n < 2; ++n) _Pragma("unroll") for (int k = 0; k < 2; ++k) \
        acc[ai2][bj2][m][n] = __builtin_amdgcn_mfma_f32_16x16x32_bf16(Bt2[n][k], At2[m][k], acc[ai2][bj2][m][n], 0, 0, 0); __builtin_amdgcn_s_setprio(0); } while (0)
#define PG8_WAIT_V(n) asm volatile("s_waitcnt vmcnt(" #n ")" ::: "memory")
#define PG8_WAIT_L(n) asm volatile("s_waitcnt lgkmcnt(" #n ")" ::: "memory")
#define PG8_BAR __builtin_amdgcn_s_barrier()
#define PG8_SCHED __builtin_amdgcn_sched_barrier(0)
    Unit cur, nxt; int ui = 0;
    if (!S.next(0, cur)) return;
    f32x4 acc[2][2][4][2];
#pragma unroll
    for (int a = 0; a < 2; ++a)
#pragma unroll
        for (int b = 0; b < 2; ++b)
#pragma unroll
            for (int m = 0; m < 4; ++m)
#pragma unroll
                for (int n = 0; n < 2; ++n) acc[a][b][m][n] = (f32x4){0.f, 0.f, 0.f, 0.f};
    bf16x8 At[4][2], B0[2][2], B1[2][2];
    const char* cA = cur.A; const char* cB = cur.B;
    if constexpr (SP2) {
        PG8_STAGE(PG8_SB(0, 0), cB, voffB); PG8_STAGE(PG8_SB(0, 1), cB + hstepB, voffB); PG8_STAGE(PG8_SA(0, 0), cA, voffA); PG8_STAGE(PG8_SA(0, 1), cA + hstepA, voffA);
        if (wr == 1) PG8_BAR;
        PG8_WAIT_V(2); PG8_BAR;
        PG8_STAGE(PG8_SB(1, 0), cB + kstepB, voffB); PG8_STAGE(PG8_SA(1, 0), cA + kstepA, voffA); PG8_STAGE(PG8_SB(1, 1), cB + hstepB + kstepB, voffB);
        PG8_WAIT_V(6); PG8_BAR;
    } else {
        PG8_STAGE(PG8_SB(0, 0), cB, voffB); PG8_STAGE(PG8_SA(0, 0), cA, voffA); PG8_STAGE(PG8_SB(0, 1), cB + hstepB, voffB); PG8_STAGE(PG8_SA(0, 1), cA + hstepA, voffA);
        if (wr == 1) PG8_BAR;
        PG8_WAIT_V(4); PG8_BAR;
        PG8_STAGE(PG8_SB(1, 0), cB + kstepB, voffB); PG8_STAGE(PG8_SA(1, 0), cA + kstepA, voffA); PG8_STAGE(PG8_SB(1, 1), cB + hstepB + kstepB, voffB);
        PG8_WAIT_V(6); PG8_BAR;
    }
    for (;;) {
        const bool has_next = S.next(ui + 1, nxt);
        const char* nA = has_next ? nxt.A : cA; const char* nB = has_next ? nxt.B : cB;
        for (int t = 0; t < nt; t += 2) {
            const bool last = (t == nt - 2);
            const char* a1 = cA + (size_t)(t + 1) * kstepA;
            const char* a2 = last ? nA : cA + (size_t)(t + 2) * kstepA; const char* b2 = last ? nB : cB + (size_t)(t + 2) * kstepB;
            const char* a3 = a2 + kstepA; const char* b3 = b2 + kstepB;
            if constexpr (Epi::MIDK > 0) { if (t == Epi::MIDK) E.mid(acc, cur, wr, fr); }
            if constexpr (SP2) {
            PG8_LDB(B0, 0, 0); PG8_LDB(B1, 0, 1); PG8_SCHED; PG8_LDA(At, 0, 0); PG8_STAGE(PG8_SA(1, 1), a1 + hstepA, voffA);
            PG8_WAIT_V(8); PG8_WAIT_L(0); PG8_BAR; PG8_MMA2(0, 0, At, B0, 0, 1, At, B1); PG8_BAR; PG8_SCHED;
            PG8_LDA(At, 0, 1); PG8_STAGE(PG8_SB(0, 0), b2, voffB); PG8_STAGE(PG8_SB(0, 1), b2 + hstepB, voffB); PG8_STAGE(PG8_SA(0, 0), a2, voffA);
            PG8_WAIT_V(8); PG8_WAIT_L(0); PG8_BAR; PG8_MMA2(1, 0, At, B0, 1, 1, At, B1); PG8_BAR; PG8_SCHED;
            PG8_LDB(B0, 1, 0); PG8_LDB(B1, 1, 1); PG8_SCHED; PG8_LDA(At, 1, 0); PG8_STAGE(PG8_SA(0, 1), a2 + hstepA, voffA);
            PG8_WAIT_V(8); PG8_WAIT_L(0); PG8_BAR; PG8_MMA2(0, 0, At, B0, 0, 1, At, B1); PG8_BAR; PG8_SCHED;
            PG8_LDA(At, 1, 1); PG8_STAGE(PG8_SB(1, 0), b3, voffB); PG8_STAGE(PG8_SB(1, 1), b3 + hstepB, voffB); PG8_STAGE(PG8_SA(1, 0), a3, voffA);
            PG8_WAIT_V(8); PG8_WAIT_L(0); PG8_BAR; PG8_MMA2(1, 0, At, B0, 1, 1, At, B1); PG8_BAR; PG8_SCHED;
            } else {
            PG8_LDB(B0, 0, 0); PG8_SCHED; PG8_LDA(At, 0, 0); PG8_STAGE(PG8_SA(1, 1), a1 + hstepA, voffA);
            PG8_WAIT_L(8); PG8_BAR; PG8_WAIT_L(0); PG8_MMA(0, 0, At, B0); PG8_BAR; PG8_SCHED;
            PG8_LDB(B1, 0, 1); PG8_STAGE(PG8_SB(0, 0), b2, voffB);
            PG8_BAR; PG8_WAIT_L(0); PG8_MMA(0, 1, At, B1); PG8_BAR;
            PG8_LDA(At, 0, 1); PG8_STAGE(PG8_SA(0, 0), a2, voffA);
            PG8_BAR; PG8_WAIT_L(0); PG8_MMA(1, 0, At, B0); PG8_BAR; PG8_SCHED;
            PG8_STAGE(PG8_SB(0, 1), b2 + hstepB, voffB);
            PG8_WAIT_V(6); PG8_BAR; PG8_MMA(1, 1, At, B1); PG8_BAR;
            PG8_LDB(B0, 1, 0); PG8_SCHED; PG8_LDA(At, 1, 0); PG8_STAGE(PG8_SA(0, 1), a2 + hstepA, voffA);
            PG8_WAIT_L(8); PG8_BAR; PG8_WAIT_L(0); PG8_MMA(0, 0, At, B0); PG8_BAR; PG8_SCHED;
            PG8_LDB(B1, 1, 1); PG8_STAGE(PG8_SB(1, 0), b3, voffB);
            PG8_BAR; PG8_WAIT_L(0); PG8_MMA(0, 1, At, B1); PG8_BAR;
            PG8_LDA(At, 1, 1); PG8_STAGE(PG8_SA(1, 0), a3, voffA);
            PG8_BAR; PG8_WAIT_L(0); PG8_MMA(1, 0, At, B0); PG8_BAR; PG8_SCHED;
            PG8_STAGE(PG8_SB(1, 1), b3 + hstepB, voffB);
            PG8_WAIT_V(6); PG8_BAR; PG8_MMA(1, 1, At, B1); PG8_BAR;
                    }
        }
        if constexpr (ALIGN_EPI) { if (wr == 0) PG8_BAR; }
        E(acc, cur, wr, wc, fr, fq);
        if (!has_next) break;
#pragma unroll
        for (int a = 0; a < 2; ++a)
#pragma unroll
            for (int b = 0; b < 2; ++b)
#pragma unroll
                for (int m = 0; m < 4; ++m)
#pragma unroll
                    for (int n = 0; n < 2; ++n) acc[a][b][m][n] = (f32x4){0.f, 0.f, 0.f, 0.f};
        cur = nxt; cA = nA; cB = nB; ++ui;
        if constexpr (ALIGN_EPI) { if (wr == 1) PG8_BAR; }
    }
    PG8_WAIT_V(0);
    if constexpr (!ALIGN_EPI) { if (wr == 0) PG8_BAR; }
    PG8_BAR;
#undef PG8_SA
#undef PG8_SB
#undef PG8_STAGE
#undef PG8_LDA
#undef PG8_LDB
#undef PG8_MMA
#undef PG8_MMA2
#undef PG8_WAIT_V
#undef PG8_WAIT_L
#undef PG8_BAR
#undef PG8_SCHED
}

template <int ACT> __device__ __forceinline__ void store_bf16_tile(const f32x4 (&acc)[2][2][4][2], bf16_t* tile, size_t ld, float scale, const LAS float* rowrs, const LAS float* colrs, int wr, int wc, int fr, int fq) {
    f32x4 cs[2][2];
#pragma unroll
    for (int bj = 0; bj < 2; ++bj)
#pragma unroll
        for (int n = 0; n < 2; ++n) { cs[bj][n] = (f32x4){scale, scale, scale, scale};
            if (colrs) cs[bj][n] = *(const LAS f32x4*)(colrs + bj * HALF + wc * 32 + 8 * fq + 4 * n) * scale; }
#pragma unroll
    for (int ai = 0; ai < 2; ++ai)
#pragma unroll
        for (int m = 0; m < 4; ++m) { const int r = ai * HALF + wr * 64 + m * 16 + fr; bf16_t* rowp = tile + (size_t)r * ld + wc * 32 + 8 * fq;
            const float rs = rowrs ? rowrs[r] : 1.f;
#pragma unroll
            for (int bj = 0; bj < 2; ++bj) { f32x4 v0 = acc[ai][bj][m][0] * cs[bj][0] * rs, v1 = acc[ai][bj][m][1] * cs[bj][1] * rs;
                if (ACT == 1) {
#pragma unroll
                    for (int j = 0; j < 4; ++j) { v0[j] = gelu_tanh(v0[j]); v1[j] = gelu_tanh(v1[j]); } }
                u32x4 o; o.x = pk_bf16(v0[0], v0[1]); o.y = pk_bf16(v0[2], v0[3]); o.z = pk_bf16(v1[0], v1[1]); o.w = pk_bf16(v1[2], v1[3]);
                *(u32x4*)(rowp + bj * HALF) = o; } }
}
struct EpiSwiglu {
    static constexpr bool PERM = true; static constexpr int MIDK = 0;
    bf16_t* O; const LAS float* tab;
    __device__ __forceinline__ void operator()(const f32x4 (&acc)[2][2][4][2], const Unit& u, int wr, int wc, int fr, int fq) const {
        char* basep = (char*)O + (((size_t)(u.pn * 2 + (wc >> 1)) * MTOK + (size_t)u.pm * BM + wr * 64 + fr) * 64 + (wc & 1) * 32 + 8 * fq) * 2;
#pragma unroll
        for (int ai = 0; ai < 2; ++ai)
#pragma unroll
            for (int m = 0; m < 4; ++m) { const int rl = ai * HALF + wr * 64 + m * 16 + fr;
                const float rs = tab[u.round * 256 + rl];
                f32x4 r0, r1;
#pragma unroll
                for (int j = 0; j < 4; ++j) { r0[j] = silu(acc[ai][0][m][0][j] * rs) * (acc[ai][1][m][0][j] * rs); r1[j] = silu(acc[ai][0][m][1][j] * rs) * (acc[ai][1][m][1][j] * rs); }
                u32x4 o; o.x = pk_bf16(r0[0], r0[1]); o.y = pk_bf16(r0[2], r0[3]); o.z = pk_bf16(r1[0], r1[1]); o.w = pk_bf16(r1[2], r1[3]);
                __builtin_nontemporal_store(o, (u32x4*)(basep + (ai * HALF + m * 16) * 128)); }
    }
};
template <int MK> struct EpiResid {
    static constexpr bool PERM = true; static constexpr int MIDK = MK;
    bf16_t* hb; float* ss; const LAS float* tab; float alpha;
    __device__ __forceinline__ void mid(f32x4 (&acc)[2][2][4][2], const Unit& u, int wr, int fr) const {
#pragma unroll
        for (int ai = 0; ai < 2; ++ai)
#pragma unroll
            for (int m = 0; m < 4; ++m) { const float ratio = tab[(u.round & 1) * 512 + ai * HALF + wr * 64 + m * 16 + fr];
#pragma unroll
                for (int bj = 0; bj < 2; ++bj)
#pragma unroll
                    for (int n = 0; n < 2; ++n) acc[ai][bj][m][n] *= ratio; }
    }
    __device__ __forceinline__ void operator()(const f32x4 (&acc)[2][2][4][2], const Unit& u, int wr, int wc, int fr, int fq) const {
        const int row0 = u.pm * BM + wr * 64 + fr, col0 = u.pn * BM + wc * 32 + 8 * fq;
#pragma unroll
        for (int ai = 0; ai < 2; ++ai)
#pragma unroll
            for (int m = 0; m < 4; ++m) { const int row = row0 + ai * HALF + m * 16; const size_t ro = (size_t)row * DM + col0; float sq = 0.f;
                const float al = (MK > 0) ? alpha * tab[(u.round & 1) * 512 + 256 + ai * HALF + wr * 64 + m * 16 + fr] : alpha;
#pragma unroll
                for (int bj = 0; bj < 2; ++bj) { const u32x4 hv = *(const u32x4*)(hb + ro + bj * HALF);
                    f32x4 s0 = (f32x4){bf_lo(hv.x), bf_hi(hv.x), bf_lo(hv.y), bf_hi(hv.y)}, s1 = (f32x4){bf_lo(hv.z), bf_hi(hv.z), bf_lo(hv.w), bf_hi(hv.w)};
                    s0 += acc[ai][bj][m][0] * al; s1 += acc[ai][bj][m][1] * al;
                    u32x4 o; o.x = pk_bf16(s0.x, s0.y); o.y = pk_bf16(s0.z, s0.w); o.z = pk_bf16(s1.x, s1.y); o.w = pk_bf16(s1.z, s1.w); *(u32x4*)(hb + ro + bj * HALF) = o;
                    sq += ((s0.x * s0.x + s0.y * s0.y) + (s0.z * s0.z + s0.w * s0.w)) + ((s1.x * s1.x + s1.y * s1.y) + (s1.z * s1.z + s1.w * s1.w)); }
                sq += __shfl_xor(sq, 16); sq += __shfl_xor(sq, 32); if (fq == 0) atomicAdd(ss + row, sq); }
    }
};
struct EpiMixIn {
    static constexpr bool PERM = true; static constexpr int MIDK = 0;
    unsigned char* ws; const LAS float* tab;
    __device__ __forceinline__ void operator()(const f32x4 (&acc)[2][2][4][2], const Unit& u, int wr, int wc, int fr, int fq) const {
        size_t off; int ld, pn = u.pn; float scale = 1.f; bool act = false; const LAS float* rowrs = nullptr; const LAS float* colrs = nullptr;
        if (u.sub == 0) { rowrs = tab + u.round * 256;
            if (pn < 8) { off = WS_ZA; ld = 2048; act = true; }
            else if (pn < 12) { off = WS_QB; ld = 1024; pn -= 8; scale = 0.08838834764831845f * 1.4426950408889634f; }
            else { off = WS_KB; ld = 1024; pn -= 12; }
        } else if (u.sub == 1) { off = WS_VT; ld = MTOK; colrs = tab + u.round * 256; }
        else { ld = 2048; if (pn < 8) off = WS_KV; else { off = WS_VTX; pn -= 8; } }
        bf16_t* tile = (bf16_t*)(ws + off) + (size_t)u.pm * BM * ld + pn * BM;
        if (act) store_bf16_tile<1>(acc, tile, ld, 1.f, rowrs, colrs, wr, wc, fr, fq);
        else store_bf16_tile<0>(acc, tile, ld, scale, rowrs, colrs, wr, wc, fr, fq);
    }
};
struct CrossPrepOrder {
    const bf16_t* kx; const bf16_t* vx; const bf16_t* wcq; const bf16_t* wcot; int G, c; size_t lda, ldb; static constexpr size_t KSA = 128, KSB = 128;
    __device__ __forceinline__ bool next(int i, Unit& u) const {
        const long L = (long)i * G + c; if (L >= 512) return false;
        const int x = (int)L & 7, j = (int)L >> 3, sub = j >> 5, jj = j & 31, h = x & 3, b = (x >> 2) * 4 + (jj & 3), t8 = jj >> 2;
        u.sub = sub; u.aux = h; u.round = i;
        if (sub == 0) { u.pm = b; u.pn = t8; u.A = (const char*)(kx + (size_t)b * 256 * DM + h * 512); u.B = (const char*)(wcq + (size_t)t8 * 256 * DM + h * 512); }
        else { u.pm = t8; u.pn = b; u.A = (const char*)(wcot + (size_t)t8 * 256 * DM + h * 512); u.B = (const char*)(vx + (size_t)b * 256 * DM + h * 512); }
        return true;
    }
};
struct EpiCrossPrep {
    static constexpr bool PERM = true; static constexpr int MIDK = 0;
    bf16_t* mt; bf16_t* vwt;
    __device__ __forceinline__ void operator()(const f32x4 (&acc)[2][2][4][2], const Unit& u, int wr, int wc, int fr, int fq) const {
        if (u.sub == 0) store_bf16_tile<0>(acc, mt + ((size_t)u.pm * 1024 + u.aux * 256) * DM + u.pn * 256, DM, 1.f, nullptr, nullptr, wr, wc, fr, fq);
        else store_bf16_tile<0>(acc, vwt + ((size_t)u.pn * DM + u.pm * 256) * 1024 + u.aux * 256, 1024, 1.f, nullptr, nullptr, wr, wc, fr, fq);
    }
};
struct CrossSOrder {
    const bf16_t* hb; const bf16_t* mt; int G, c; size_t lda, ldb; static constexpr size_t KSA = 128, KSB = 128;
    __device__ __forceinline__ bool next(int i, Unit& u) const {
        const long L = (long)i * G + c; if (L >= 256) return false;
        const int b = (int)L & 7, j = (int)L >> 3, h = j & 3, mtile = j >> 2;
        u.A = (const char*)(hb + ((size_t)b * SEQ + 256 * mtile) * DM); u.B = (const char*)(mt + ((size_t)b * 1024 + h * 256) * DM); u.pm = b * 8 + mtile; u.pn = h; u.sub = 0; u.round = i; u.aux = 0; return true;
    }
};
struct EpiSoftmax {
    static constexpr bool PERM = true; static constexpr int MIDK = 0;
    bf16_t* P; LAS float* xch; const LAS float* rtab; float scale;
    __device__ __forceinline__ void operator()(f32x4 (&acc)[2][2][4][2], const Unit& u, int wr, int wc, int fr, int fq) const {
        float st[2][4];
#pragma unroll
        for (int ai = 0; ai < 2; ++ai)
#pragma unroll
            for (int m = 0; m < 4; ++m) { float v = -3.0e38f; const float rs = rtab[(u.round & 1) * 256 + ai * HALF + wr * 64 + m * 16 + fr] * scale;
#pragma unroll
                for (int bj = 0; bj < 2; ++bj)
#pragma unroll
                    for (int n = 0; n < 2; ++n) { acc[ai][bj][m][n] *= rs;
#pragma unroll
                        for (int j = 0; j < 4; ++j) v = fmaxf(v, acc[ai][bj][m][n][j]); }
                v = fmaxf(v, __shfl_xor(v, 16)); v = fmaxf(v, __shfl_xor(v, 32)); st[ai][m] = v; }
        if (fq == 0) {
#pragma unroll
            for (int ai = 0; ai < 2; ++ai)
#pragma unroll
                for (int m = 0; m < 4; ++m) xch[(ai * HALF + wr * 64 + m * 16 + fr) * 4 + wc] = st[ai][m]; }
        LDS_WAIT(); __builtin_amdgcn_s_barrier();
#pragma unroll
        for (int ai = 0; ai < 2; ++ai)
#pragma unroll
            for (int m = 0; m < 4; ++m) { const f32x4 t = *(const LAS f32x4*)(xch + (ai * HALF + wr * 64 + m * 16 + fr) * 4); const float mx = fmaxf(fmaxf(t.x, t.y), fmaxf(t.z, t.w)); float s = 0.f;
#pragma unroll
                for (int bj = 0; bj < 2; ++bj)
#pragma unroll
                    for (int n = 0; n < 2; ++n)
#pragma unroll
                        for (int j = 0; j < 4; ++j) { const float e = __builtin_amdgcn_exp2f(acc[ai][bj][m][n][j] - mx); acc[ai][bj][m][n][j] = e; s += e; }
                s += __shfl_xor(s, 16); s += __shfl_xor(s, 32); st[ai][m] = s; }
        if (fq == 0) {
#pragma unroll
            for (int ai = 0; ai < 2; ++ai)
#pragma unroll
                for (int m = 0; m < 4; ++m) xch[1024 + (ai * HALF + wr * 64 + m * 16 + fr) * 4 + wc] = st[ai][m]; }
        LDS_WAIT(); __builtin_amdgcn_s_barrier();
#pragma unroll
        for (int ai = 0; ai < 2; ++ai)
#pragma unroll
            for (int m = 0; m < 4; ++m) { const f32x4 t = *(const LAS f32x4*)(xch + 1024 + (ai * HALF + wr * 64 + m * 16 + fr) * 4); const float inv = 1.f / ((t.x + t.y) + (t.z + t.w));
                bf16_t* rowp = P + (size_t)(u.pm * BM + ai * HALF + wr * 64 + m * 16 + fr) * 1024 + u.pn * 256 + wc * 32 + 8 * fq;
#pragma unroll
                for (int bj = 0; bj < 2; ++bj) { const f32x4 v0 = acc[ai][bj][m][0] * inv, v1 = acc[ai][bj][m][1] * inv;
                    u32x4 o; o.x = pk_bf16(v0[0], v0[1]); o.y = pk_bf16(v0[2], v0[3]); o.z = pk_bf16(v1[0], v1[1]); o.w = pk_bf16(v1[2], v1[3]);
                    *(u32x4*)(rowp + bj * HALF) = o; } }
    }
};
struct CrossOutOrder {
    const bf16_t* P; const bf16_t* vwt; int G, c; size_t lda, ldb; static constexpr size_t KSA = 128, KSB = 128;
    __device__ __forceinline__ bool next(int i, Unit& u) const {
        const long L = (long)i * G + c; if (L >= 512) return false;
        const int b = (int)L & 7, j = (int)L >> 3, nt = j & 7, mtile = j >> 3;
        u.A = (const char*)(P + ((size_t)b * SEQ + 256 * mtile) * 1024); u.B = (const char*)(vwt + ((size_t)b * DM + 256 * nt) * 1024); u.pm = b * 8 + mtile; u.pn = nt; u.sub = 0; u.round = i; u.aux = 0; return true;
    }
};
struct EpiNone { static constexpr bool PERM = true; static constexpr int MIDK = 0; float* sink;
    __device__ __forceinline__ void operator()(const f32x4 (&acc)[2][2][4][2], const Unit& u, int wr, int wc, int fr, int fq) const {
        float s = 0.f;
#pragma unroll
        for (int ai = 0; ai < 2; ++ai)
#pragma unroll
            for (int bj = 0; bj < 2; ++bj)
#pragma unroll
                for (int m = 0; m < 4; ++m)
#pragma unroll
                    for (int n = 0; n < 2; ++n) s += acc[ai][bj][m][n][0] + acc[ai][bj][m][n][1] + acc[ai][bj][m][n][2] + acc[ai][bj][m][n][3];
        if (s == 123.456f) *sink = s; } };
struct EpiBf16 {
    static constexpr bool PERM = true; static constexpr int MIDK = 0;
    bf16_t* O; int ld; float scale;
    __device__ __forceinline__ void operator()(const f32x4 (&acc)[2][2][4][2], const Unit& u, int wr, int wc, int fr, int fq) const {
        store_bf16_tile<0>(acc, O + (size_t)u.pm * BM * ld + u.pn * BM, ld, scale, nullptr, nullptr, wr, wc, fr, fq);
    }
};
}

struct TrItem { const float* W; bf16_t* WT; const float* gain; const float* gainhi; int K, N, mode, item, blocked; };
__device__ __forceinline__ void tr_load(const TrItem& t, float (&r)[32], int lane) {
    const int nblk = t.N / 32, kb = t.item / nblk, nb = t.item % nblk; const float* src = t.W + (size_t)(64 * kb + (lane >> 5)) * t.N + 32 * nb + (lane & 31);
#pragma unroll
    for (int i = 0; i < 32; ++i) r[i] = src[(size_t)(2 * i) * t.N];
}
__device__ __forceinline__ void tr_store(const TrItem& t, LAS float* scr, int lane) {
    const int nblk = t.N / 32, kb = t.item / nblk, nb = t.item % nblk, k0 = 64 * kb, n0 = 32 * nb;
    int d0 = n0;
    if (t.mode == 1) { const int bj = n0 / DFF, rr = n0 % DFF; d0 = 256 * (rr / 128) + 128 * bj + (rr % 128); }
    LDS_WAIT();
    const int c = lane & 7;
    f32x4 g0 = {1.f, 1.f, 1.f, 1.f}, g1 = g0;
    if (t.gain) { const float* gp = (t.gainhi && k0 >= 1024) ? t.gainhi - 1024 : t.gain; g0 = *(const f32x4*)(gp + k0 + 8 * c); g1 = *(const f32x4*)(gp + k0 + 8 * c + 4); }
#pragma unroll
    for (int j = 0; j < 4; ++j) { const int n = (lane >> 3) + 8 * j; const LAS float* s = scr + (8 * c) * 33 + n;
        u32x4 o; o.x = pk_bf16(s[0 * 33] * g0.x, s[1 * 33] * g0.y); o.y = pk_bf16(s[2 * 33] * g0.z, s[3 * 33] * g0.w); o.z = pk_bf16(s[4 * 33] * g1.x, s[5 * 33] * g1.y); o.w = pk_bf16(s[6 * 33] * g1.z, s[7 * 33] * g1.w);
        bf16_t* dst = t.blocked ? t.WT + ((size_t)kb * t.N + d0 + n) * 64 + 8 * c : t.WT + (size_t)(d0 + n) * t.K + k0 + 8 * c;
        *(u32x4*)dst = o; }
    LDS_WAIT();
}
__device__ __forceinline__ void rms_row_to_bf16(const float* xrow, const float* gain, bf16_t* orow, int lane) {
    const f32x4* xr = (const f32x4*)xrow + lane; const f32x4* gr = (const f32x4*)gain + lane;
    f32x4 v[8]; float s = 0.f;
#pragma unroll
    for (int j = 0; j < 8; ++j) { v[j] = xr[64 * j]; s += (v[j].x * v[j].x + v[j].y * v[j].y) + (v[j].z * v[j].z + v[j].w * v[j].w); }
    const float rstd = rsqrtf(wave_sum(s) * (1.f / DM) + EPS);
    u32x2* o8 = (u32x2*)orow + lane;
#pragma unroll
    for (int j = 0; j < 8; ++j) { const f32x4 g = gr[64 * j]; u32x2 o; o.x = pk_bf16(v[j].x * rstd * g.x, v[j].y * rstd * g.y); o.y = pk_bf16(v[j].z * rstd * g.z, v[j].w * rstd * g.w); o8[64 * j] = o; }
}
__device__ __forceinline__ void rms_rows_phase(const float* src, const float* gain, bf16_t* dst, int rows, int gw, int ngw, int lane) {
    for (int r = gw; r < rows; r += ngw) rms_row_to_bf16(src + (size_t)r * DM, gain, dst + (size_t)r * DM, lane);
}

__device__ __forceinline__ bool tr_pick(const Params& p, int it, TrItem& t) {
    constexpr int I_IN = (DM / 64) * (2 * DFF / 32), I_OUT = (DFF / 64) * (DM / 32), I_MIXIN = (DM / 64) * (5120 / 32), I_SQ = (DM / 64) * (DM / 32), I_CKV = (DM / 64) * (4096 / 32);
    constexpr int NITEMS = 2 * I_IN + 2 * I_OUT + I_MIXIN + 2 * I_SQ + I_CKV;
    if (it >= NITEMS) return false;
    int r = it; t.gain = nullptr; t.gainhi = nullptr; t.mode = 0; t.blocked = 0;
    if (r < I_IN) { t.W = p.ffn1_w_in; t.WT = (bf16_t*)(p.ws + WS_WT_IN1); t.K = DM; t.N = 2 * DFF; t.mode = 1; t.gain = p.ffn1_norm; t.item = r; return true; } r -= I_IN;
    if (r < I_OUT) { t.W = p.ffn1_w_out; t.WT = (bf16_t*)(p.ws + WS_WT_OUT1); t.K = DFF; t.N = DM; t.blocked = 1; t.item = r; return true; } r -= I_OUT;
    if (r < I_MIXIN) { t.W = p.w_mix_in; t.WT = (bf16_t*)(p.ws + WS_WT_MIXIN); t.K = DM; t.N = 5120; t.gain = p.mix_norm; t.item = r; return true; } r -= I_MIXIN;
    if (r < I_SQ) { t.W = p.w_mix_out; t.WT = (bf16_t*)(p.ws + WS_WT_MIXOUT); t.K = DM; t.N = DM; t.gain = p.gnorm_a; t.gainhi = p.gnorm_b; t.item = r; return true; } r -= I_SQ;
    if (r < I_CKV) { t.W = p.w_ckv; t.WT = (bf16_t*)(p.ws + WS_WT_CKV); t.K = DM; t.N = 4096; t.item = r; return true; } r -= I_CKV;
    if (r < I_SQ) { t.W = p.w_co; t.WT = (bf16_t*)(p.ws + WS_WT_CO); t.K = DM; t.N = DM; t.item = r; return true; } r -= I_SQ;
    if (r < I_IN) { t.W = p.ffn2_w_in; t.WT = (bf16_t*)(p.ws + WS_WT_IN2); t.K = DM; t.N = 2 * DFF; t.mode = 1; t.gain = p.ffn2_norm; t.item = r; return true; } r -= I_IN;
    t.W = p.ffn2_w_out; t.WT = (bf16_t*)(p.ws + WS_WT_OUT2); t.K = DFF; t.N = DM; t.blocked = 1; t.item = r; return true;
}
__device__ __forceinline__ void phase_prologue(const Params& p, LAS unsigned char* lds, int gw, int ngw, int wave, int lane) {
    LAS float* scr = (LAS float*)(lds + wave * 16384);
    { float* ssz = (float*)(p.ws + WS_SS) + MTOK; for (int i = gw * 64 + lane; i < 6 * MTOK; i += ngw * 64) ssz[i] = 0.f; }
    TrItem cur, nxt; float r[32];
    bool have = tr_pick(p, gw, cur);
    if (have) tr_load(cur, r, lane);
    for (int it = gw; have; it += ngw) {
        const bool hn = tr_pick(p, it + ngw, nxt);
#pragma unroll
        for (int i = 0; i < 32; ++i) scr[(2 * i + (lane >> 5)) * 33 + (lane & 31)] = r[i];
        if (hn) tr_load(nxt, r, lane);
        tr_store(cur, scr, lane);
        cur = nxt; have = hn;
    }
    for (int r = gw; r < MTOK; r += ngw) {
        const f32x4* xr = (const f32x4*)(p.x + (size_t)r * DM) + lane; u32x2* o8 = (u32x2*)((bf16_t*)(p.ws + WS_HB) + (size_t)r * DM) + lane; float s = 0.f;
        f32x4 v[8];
#pragma unroll
        for (int j = 0; j < 8; ++j) { v[j] = xr[64 * j]; s += (v[j].x * v[j].x + v[j].y * v[j].y) + (v[j].z * v[j].z + v[j].w * v[j].w); }
#pragma unroll
        for (int j = 0; j < 8; ++j) { u32x2 o; o.x = pk_bf16(v[j].x, v[j].y); o.y = pk_bf16(v[j].z, v[j].w); o8[64 * j] = o; }
        s = wave_sum(s); if (lane == 0) ((float*)(p.ws + WS_SS))[r] = s;
    }
    rms_rows_phase(p.mem, p.mem_norm, (bf16_t*)(p.ws + WS_MEMN), MEMROWS, gw, ngw, lane);
    for (int r = gw; r < DM; r += ngw) {
        const f32x4* xr = (const f32x4*)(p.w_cq + (size_t)r * DM) + lane; u32x2* o8 = (u32x2*)((bf16_t*)(p.ws + WS_WT_CQ) + (size_t)r * DM) + lane; const float gk = p.cross_norm[r];
#pragma unroll
        for (int j = 0; j < 8; ++j) { const f32x4 v = xr[64 * j]; u32x2 o; o.x = pk_bf16(v.x * gk, v.y * gk); o.y = pk_bf16(v.z * gk, v.w * gk); o8[64 * j] = o; }
    }
}

__device__ __forceinline__ void phase_final_norm(const Params& p, int gw, int ngw, int lane) {
    const bf16_t* H = (const bf16_t*)(p.ws + WS_HB); const float* ss4 = (const float*)(p.ws + WS_SS) + 4 * MTOK;
    for (int r = gw; r < MTOK; r += ngw) {
        const u32x4* hr = (const u32x4*)(H + (size_t)r * DM) + lane; f32x4* orow = (f32x4*)(p.out + (size_t)r * DM);
        const float rs = rstd_of(ss4[r]);
#pragma unroll
        for (int j = 0; j < 4; ++j) { const u32x4 h = hr[64 * j]; const int c4 = (64 * j + lane) * 2; const f32x4 g0 = ((const f32x4*)p.final_norm)[c4], g1 = ((const f32x4*)p.final_norm)[c4 + 1];
            __builtin_nontemporal_store((f32x4){bf_lo(h.x) * rs * g0.x, bf_hi(h.x) * rs * g0.y, bf_lo(h.y) * rs * g0.z, bf_hi(h.y) * rs * g0.w}, orow + c4);
            __builtin_nontemporal_store((f32x4){bf_lo(h.z) * rs * g1.x, bf_hi(h.z) * rs * g1.y, bf_lo(h.w) * rs * g1.z, bf_hi(h.w) * rs * g1.w}, orow + c4 + 1); }
    }
}

__device__ __forceinline__ void phase_ynorm(const Params& p, int gw, int ngw, int lane) {
    bf16_t* Y = (bf16_t*)(p.ws + WS_XN);
    for (int r = gw; r < MTOK; r += ngw) {
        u32x4* yr = (u32x4*)(Y + (size_t)r * DM) + lane;
        u32x4 v[4]; float ss[2] = {0.f, 0.f};
#pragma unroll
        for (int j = 0; j < 4; ++j) { v[j] = yr[64 * j]; float s = 0.f;
#pragma unroll
            for (int e = 0; e < 4; ++e) { const float a = bf_lo(v[j][e]), b = bf_hi(v[j][e]); s += a * a + b * b; }
            ss[j >> 1] += s; }
        const float ra = rsqrtf(wave_sum(ss[0]) * (1.f / 1024) + EPS), rb = rsqrtf(wave_sum(ss[1]) * (1.f / 1024) + EPS);
#pragma unroll
        for (int j = 0; j < 4; ++j) { const float rs = (j < 2) ? ra : rb; const float* g = ((j < 2) ? p.gnorm_a : p.gnorm_b) + (j & 1) * 512 + lane * 8;
            const f32x4 g0 = *(const f32x4*)g, g1 = *(const f32x4*)(g + 4); u32x4 o;
            o.x = pk_bf16(bf_lo(v[j].x) * rs * g0.x, bf_hi(v[j].x) * rs * g0.y); o.y = pk_bf16(bf_lo(v[j].y) * rs * g0.z, bf_hi(v[j].y) * rs * g0.w);
            o.z = pk_bf16(bf_lo(v[j].z) * rs * g1.x, bf_hi(v[j].z) * rs * g1.y); o.w = pk_bf16(bf_lo(v[j].w) * rs * g1.z, bf_hi(v[j].w) * rs * g1.w);
            yr[64 * j] = o; }
    }
}

__device__ __forceinline__ void phase_sgu_mfma(const Params& p, LAS unsigned char* lds, int wave, int lane, int first, int stride) {
    constexpr int VS = 272;
    const bf16_t* za = (const bf16_t*)(p.ws + WS_ZA); bf16_t* Y = (bf16_t*)(p.ws + WS_XN);
    const int l32 = lane & 31, hh = lane >> 5, tt = wave >> 1, cpair = wave & 1;
    for (int item = first; item < NB * 16 * 8; item += stride) {
        const int g = item & 7, n = (item >> 3) & 15, b = item >> 7; const size_t row0 = (size_t)b * SEQ + n * 128;
        const int t = 32 * tt + l32;
        unsigned vv[16];
#pragma unroll
        for (int r = 0; r < 16; ++r) vv[r] = *(const unsigned*)(za + (row0 + wave + 8 * r) * 2048 + 1024 + g * 128 + 2 * lane);
        const float* wrow = p.spatial_w + ((size_t)g * 128 + t) * 128 + 8 * hh;
        f32x4 w0[8], w1[8];
#pragma unroll
        for (int ks = 0; ks < 8; ++ks) if (ks < 4 || tt >= 2) { w0[ks] = *(const f32x4*)(wrow + 16 * ks); w1[ks] = *(const f32x4*)(wrow + 16 * ks + 4); }
        u32x2 uu[2][4];
#pragma unroll
        for (int ci = 0; ci < 2; ++ci)
#pragma unroll
            for (int cg4 = 0; cg4 < 4; ++cg4) uu[ci][cg4] = *(const u32x2*)(za + (row0 + t) * 2048 + g * 128 + 32 * (2 * cpair + ci) + 8 * cg4 + 4 * hh);
        const float bias = p.spatial_b[g * 128 + t]; float sqa = 0.f;
        const float g0 = p.ln_v_gain[g * 128 + 2 * lane], g1 = p.ln_v_gain[g * 128 + 2 * lane + 1], b0 = p.ln_v_bias[g * 128 + 2 * lane], b1 = p.ln_v_bias[g * 128 + 2 * lane + 1];
#pragma unroll
        for (int r = 0; r < 16; ++r) { const int s = wave + 8 * r;
            const float a = bf_lo(vv[r]), c = bf_hi(vv[r]);
            const float mu = wave_sum(a + c) * (1.f / 128); const float da = a - mu, dc = c - mu;
            const float var = wave_sum(da * da + dc * dc) * (1.f / 128); const float rstd = rsqrtf(var + EPS);
            const unsigned o = pk_bf16(da * rstd * g0 + b0, dc * rstd * g1 + b1);
            *(LAS bf16_t*)(lds + (2 * lane) * VS + s * 2) = (bf16_t)(o & 0xffffu); *(LAS bf16_t*)(lds + (2 * lane + 1) * VS + s * 2) = (bf16_t)(o >> 16);
        }
        __syncthreads();
        f32x16 acc[2];
#pragma unroll
        for (int i = 0; i < 16; ++i) { acc[0][i] = 0.f; acc[1][i] = 0.f; }
#pragma unroll
        for (int ks = 0; ks < 8; ++ks) if (ks < 4 || tt >= 2) {
            u32x4 wb; wb.x = pk_bf16(w0[ks].x, w0[ks].y); wb.y = pk_bf16(w0[ks].z, w0[ks].w); wb.z = pk_bf16(w1[ks].x, w1[ks].y); wb.w = pk_bf16(w1[ks].z, w1[ks].w);
            const bf16x8 bfrag = __builtin_bit_cast(bf16x8, wb);
#pragma unroll
            for (int ci = 0; ci < 2; ++ci) { const bf16x8 a = *(const LAS bf16x8*)(lds + (32 * (2 * cpair + ci) + l32) * VS + (16 * ks + 8 * hh) * 2); acc[ci] = MFMA32(a, bfrag, acc[ci]); }
        }
#pragma unroll
        for (int ci = 0; ci < 2; ++ci)
#pragma unroll
            for (int cg4 = 0; cg4 < 4; ++cg4) { const int c = 32 * (2 * cpair + ci) + 8 * cg4 + 4 * hh; const size_t o = (row0 + t) * 2048 + g * 128 + c;
                const u32x2 u2 = uu[ci][cg4]; u32x2 r;
                r.x = pk_bf16(bf_lo(u2.x) * (acc[ci][4 * cg4] + bias), bf_hi(u2.x) * (acc[ci][4 * cg4 + 1] + bias));
                r.y = pk_bf16(bf_lo(u2.y) * (acc[ci][4 * cg4 + 2] + bias), bf_hi(u2.y) * (acc[ci][4 * cg4 + 3] + bias));
                *(u32x2*)(Y + o) = r;
                sqa += (bf_lo(r.x) * bf_lo(r.x) + bf_hi(r.x) * bf_hi(r.x)) + (bf_lo(r.y) * bf_lo(r.y) + bf_hi(r.y) * bf_hi(r.y)); }
        sqa += __shfl_xor(sqa, 32); if (hh == 0) atomicAdd((float*)(p.ws + WS_SS) + 5 * MTOK + row0 + t, sqa);
        __syncthreads();
    }
}
__device__ __forceinline__ void phase_stick_mfma(const Params& p, LAS unsigned char* lds, int wave, int lane) {
    constexpr int KSTR = 272, VSTR = 136, KBYTES = 64 * KSTR, BUFB = KBYTES + 128 * VSTR;
    const bf16_t* qb = (const bf16_t*)(p.ws + WS_QB); const bf16_t* kb = (const bf16_t*)(p.ws + WS_KB); const bf16_t* vT = (const bf16_t*)(p.ws + WS_VT);
    bf16_t* Y = (bf16_t*)(p.ws + WS_XN);
    const int tid = opaque_tid(), l32 = lane & 31, hh = lane >> 5;
    for (int item = blockIdx.x; item < 256; item += gridDim.x) {
        const int pr = item & 3, head = (item >> 2) & 7, b = item >> 5;
        const bf16_t* kbase = kb + (size_t)b * SEQ * 1024 + head * 128;
        const bf16_t* vbase = vT + (size_t)(head * 128) * MTOK + (size_t)b * SEQ;
        for (int pass = 0; pass < 2; ++pass) {
            const int I = pass ? pr : 7 - pr;
            const int tw = 256 * I + 32 * wave;
            bf16x8 qf[8];
            { const bf16_t* qrow = qb + ((size_t)b * SEQ + tw + l32) * 1024 + head * 128 + 8 * hh;
#pragma unroll
              for (int kd = 0; kd < 8; ++kd) qf[kd] = *(const bf16x8*)(qrow + 16 * kd); }
            f32x16 oacc[4];
#pragma unroll
            for (int dt = 0; dt < 4; ++dt)
#pragma unroll
                for (int i = 0; i < 16; ++i) oacc[dt][i] = 0.f;
            float R = 0.f;
            const int jmax = 4 * I + 3;
            u32x4 kr[2], vr[2];
            unsigned koff[2], voff[2];
#pragma unroll
            for (int i_ = 0; i_ < 2; ++i_) { const int c_ = tid + 512 * i_; koff[i_] = (unsigned)(((64 * jmax + (c_ >> 4)) * 1024 + (c_ & 15) * 8) * 2); voff[i_] = (unsigned)((c_ >> 3) * (MTOK * 2) + (64 * jmax + (c_ & 7) * 8) * 2); }
#define STK_LOAD() do { _Pragma("unroll") for (int i_ = 0; i_ < 2; ++i_) { kr[i_] = *(const u32x4*)((const char*)kbase + koff[i_]); vr[i_] = *(const u32x4*)((const char*)vbase + voff[i_]); koff[i_] -= 64 * 1024 * 2; voff[i_] -= 128; } } while (0)
            STK_LOAD();
            for (int j = jmax; j >= 0; --j) {
                LAS unsigned char* bufp = lds + (j & 1) * BUFB;
#pragma unroll
                for (int i_ = 0; i_ < 2; ++i_) { const int c_ = tid + 512 * i_;
                    *(LAS u32x4*)(bufp + (c_ >> 4) * KSTR + (c_ & 15) * 16) = kr[i_];
                    LAS u32x2* vp = (LAS u32x2*)(bufp + KBYTES + (c_ >> 3) * VSTR + (c_ & 7) * 16); vp[0] = (u32x2){vr[i_].x, vr[i_].y}; vp[1] = (u32x2){vr[i_].z, vr[i_].w}; }
                const bool alive = __builtin_amdgcn_ballot_w64(R >= -160.f) != 0ull;
                if (lane == 0) *(volatile LAS unsigned*)(lds + 2 * BUFB + ((j & 1) * 8 + wave) * 4) = alive ? 1u : 0u;
                __syncthreads();
                { const u32x4 f0 = *(const LAS u32x4*)(lds + 2 * BUFB + (j & 1) * 32), f1 = *(const LAS u32x4*)(lds + 2 * BUFB + (j & 1) * 32 + 16);
                  if (((f0.x | f0.y) | (f0.z | f0.w) | (f1.x | f1.y) | (f1.z | f1.w)) == 0u) break; }
                if (j > 0) STK_LOAD();
                const int k0 = 64 * j;
                if (alive && k0 <= tw + 30) {
                    const bool diag = (k0 + 63 >= tw); const int t = tw + l32;
                    float run = R;
#pragma unroll
                    for (int ks = 1; ks >= 0; --ks) {
                        f32x16 s, lm;
#pragma unroll
                        for (int i = 0; i < 16; ++i) s[i] = 0.f;
#pragma unroll
                        for (int kd = 0; kd < 8; ++kd) { const bf16x8 a = *(const LAS bf16x8*)(bufp + (32 * ks + l32) * KSTR + (16 * kd + 8 * hh) * 2); s = MFMA32(a, qf[kd], s); }
                        if (diag) {
#pragma unroll
                            for (int i = 0; i < 16; ++i) { const int key = k0 + 32 * ks + 8 * (i >> 2) + 4 * hh + (i & 3); if (key >= t) s[i] = -1.0e30f; } }
#pragma unroll
                        for (int i = 0; i < 16; ++i) { const float z = s[i]; const float e = __builtin_amdgcn_exp2f(-fabsf(z)); lm[i] = -(fmaxf(z, 0.f) + __builtin_amdgcn_logf(1.f + e)); }
                        float gs[4], og[4];
#pragma unroll
                        for (int c4 = 0; c4 < 4; ++c4) { gs[c4] = (lm[4 * c4] + lm[4 * c4 + 1]) + (lm[4 * c4 + 2] + lm[4 * c4 + 3]); og[c4] = __shfl_xor(gs[c4], 32); }
#pragma unroll
                        for (int c4 = 3; c4 >= 0; --c4) {
                            const float r3 = run + (hh == 0 ? og[c4] : 0.f);
                            const float r2 = r3 + lm[4 * c4 + 3], r1 = r2 + lm[4 * c4 + 2], r0 = r1 + lm[4 * c4 + 1];
                            s[4 * c4 + 3] = __builtin_amdgcn_exp2f(s[4 * c4 + 3] + lm[4 * c4 + 3] + r3);
                            s[4 * c4 + 2] = __builtin_amdgcn_exp2f(s[4 * c4 + 2] + lm[4 * c4 + 2] + r2);
                            s[4 * c4 + 1] = __builtin_amdgcn_exp2f(s[4 * c4 + 1] + lm[4 * c4 + 1] + r1);
                            s[4 * c4] = __builtin_amdgcn_exp2f(s[4 * c4] + lm[4 * c4] + r0);
                            run += gs[c4] + og[c4]; }
#pragma unroll
                        for (int kk = 0; kk < 2; ++kk) {
                            u32x4 pw; pw.x = pk_bf16(s[8 * kk], s[8 * kk + 1]); pw.y = pk_bf16(s[8 * kk + 2], s[8 * kk + 3]); pw.z = pk_bf16(s[8 * kk + 4], s[8 * kk + 5]); pw.w = pk_bf16(s[8 * kk + 6], s[8 * kk + 7]);
                            const bf16x8 pf = __builtin_bit_cast(bf16x8, pw);
#pragma unroll
                            for (int dt = 0; dt < 4; ++dt) { const LAS unsigned char* va = bufp + KBYTES + (32 * dt + l32) * VSTR + (32 * ks + 16 * kk + 4 * hh) * 2;
                                const u32x2 v0 = *(const LAS u32x2*)va, v1 = *(const LAS u32x2*)(va + 16);
                                const u32x4 vw = {v0.x, v0.y, v1.x, v1.y};
                                oacc[dt] = MFMA32(__builtin_bit_cast(bf16x8, vw), pf, oacc[dt]); } }
                    }
                    R = run;
                }
            }
#undef STK_LOAD
            __syncthreads();
            bf16_t* yrow = Y + ((size_t)b * SEQ + tw + l32) * 2048 + 1024 + head * 128 + 4 * hh; float sqb = 0.f;
#pragma unroll
            for (int dt = 0; dt < 4; ++dt)
#pragma unroll
                for (int c4 = 0; c4 < 4; ++c4) { u32x2 r; r.x = pk_bf16(oacc[dt][4 * c4], oacc[dt][4 * c4 + 1]); r.y = pk_bf16(oacc[dt][4 * c4 + 2], oacc[dt][4 * c4 + 3]); *(u32x2*)(yrow + 32 * dt + 8 * c4) = r;
                    sqb += (bf_lo(r.x) * bf_lo(r.x) + bf_hi(r.x) * bf_hi(r.x)) + (bf_lo(r.y) * bf_lo(r.y) + bf_hi(r.y) * bf_hi(r.y)); }
            sqb += __shfl_xor(sqb, 32); if (hh == 0) atomicAdd((float*)(p.ws + WS_SS) + 6 * MTOK + (size_t)b * SEQ + tw + l32, sqb);
        }
    }
}

#define XB_TMO      128
#define XB_XCNT(j)  (256  + 64 * (j))
#define XB_XSUB(j)  (1280 + 64 * (j))
#define XB_XGEN(j)  (2304 + 64 * (j))
#define XB_TOP      3328
#define XB_TOPGEN   3392
#define XCD_BAR_WORDS 3456
#define XB_SPIN_CAP (1u << 20)
__device__ __forceinline__ unsigned xb_ld(unsigned* p)              { return __hip_atomic_load(p, __ATOMIC_RELAXED, __HIP_MEMORY_SCOPE_AGENT); }
__device__ __forceinline__ unsigned xb_add(unsigned* p, unsigned v) { return __hip_atomic_fetch_add(p, v, __ATOMIC_RELAXED, __HIP_MEMORY_SCOPE_AGENT); }
__device__ __forceinline__ unsigned xb_xcc_id() { return (unsigned)__builtin_amdgcn_s_getreg((3 << 11) | 20) & 0xFu; }
#define XB_SPIN(cond, bar) do { unsigned _sp = 0; while (cond) { __builtin_amdgcn_s_sleep(1); \
    if ((++_sp & 255u) == 0u) { if (xb_ld(&(bar)[XB_TMO])) break; if (_sp > XB_SPIN_CAP) { atomicAdd(&(bar)[XB_TMO], 1u); break; } } } } while (0)
__device__ __forceinline__ void xcd_barrier_post(unsigned* bar) { if (threadIdx.x == 0) (void)xb_add(&bar[XB_XCNT(xb_xcc_id())], 1u); }
__device__ __forceinline__ void xcd_barrier_complete(unsigned* bar, unsigned x, unsigned& nloc, unsigned& nx) {
    const unsigned G = gridDim.x * gridDim.y * gridDim.z;
    unsigned sum, cnt, mine, sp = 0u;
    for (;;) {
        sum = 0u; cnt = 0u; mine = 0u;
#pragma unroll
        for (unsigned j = 0; j < 16; ++j) { const unsigned c = xb_ld(&bar[XB_XCNT(j)]); sum += c; cnt += (c > 0u) ? 1u : 0u; mine = (j == x) ? c : mine; }
        if (sum == G) break;
        __builtin_amdgcn_s_sleep(1);
        if ((++sp & 255u) == 0u) { if (xb_ld(&bar[XB_TMO])) break; if (sp > XB_SPIN_CAP) { atomicAdd(&bar[XB_TMO], 1u); break; } }
    }
    nloc = mine > 0u ? mine : 1u; nx = cnt > 0u ? cnt : 1u;
}
__device__ __forceinline__ void xcd_barrier(unsigned* bar, volatile LAS unsigned* st) {
    asm volatile("s_waitcnt vmcnt(0)" ::: "memory");
    __syncthreads();
    if (threadIdx.x == 0) {
        const unsigned x = xb_xcc_id();
        __builtin_amdgcn_s_waitcnt(0);
        unsigned nloc = st[0], nx = st[1];
        if (nloc == 0u) { xcd_barrier_complete(bar, x, nloc, nx); st[0] = nloc; st[1] = nx; }
        const unsigned old = xb_add(&bar[XB_XSUB(x)], 1u);
        const unsigned gen = old / nloc;
        if (old + 1u == (gen + 1u) * nloc) {
            __builtin_amdgcn_fence(__ATOMIC_RELEASE, "agent");
            asm volatile("s_waitcnt vmcnt(0)" ::: "memory");
            const unsigned og = xb_add(&bar[XB_TOP], 1u);
            const unsigned tg = og / nx;
            if (og + 1u == (tg + 1u) * nx) xb_add(&bar[XB_TOPGEN], 1u);
            else XB_SPIN(xb_ld(&bar[XB_TOPGEN]) == tg, bar);
            __builtin_amdgcn_fence(__ATOMIC_ACQUIRE, "agent");
            xb_add(&bar[XB_XGEN(x)], 1u);
            asm volatile("s_waitcnt vmcnt(0)" ::: "memory");
        } else {
            XB_SPIN(xb_ld(&bar[XB_XGEN(x)]) == gen, bar);
            __builtin_amdgcn_fence(__ATOMIC_ACQUIRE, "agent");
            asm volatile("s_waitcnt vmcnt(0)" ::: "memory");
        }
    }
    __syncthreads();
}

constexpr int NPHASES = 12;
constexpr int LDS_BYTES = 144 * 1024;

__global__ __launch_bounds__(512, 2) void mega(Params p) {
    extern __shared__ __attribute__((aligned(16))) unsigned char shm[];
    LAS unsigned char* lds = (LAS unsigned char*)shm;
    cg::grid_group grid = cg::this_grid();
    const int ngw = gridDim.x * 8;
    unsigned* const xbar = (unsigned*)(p.ws + WS_BAR);
    volatile LAS unsigned* const xst = (volatile LAS unsigned*)(lds + LDS_BYTES - 16);
    if (threadIdx.x == 0) { xst[0] = 0u; xst[1] = 0u; }
    __syncthreads();
    xcd_barrier_post(xbar);
    const int G = gridDim.x, c = blockIdx.x;
    unsigned char* ws = p.ws;
#define PH_BEGIN(n) if (p.ph_lo <= (n) && (n) < p.ph_hi) { const int tid_ = opaque_tid(); const int wave = tid_ >> 6, lane = tid_ & 63, gw = blockIdx.x * 8 + wave; (void)gw; (void)lane;
#define PH_END(n) } if (p.ph_lo <= (n) && (n) + 1 < p.ph_hi) { if (p.ph_hi > NPHASES) grid.sync(); else xcd_barrier(xbar, xst); }
#define GEMM_SWIGLU(AOFF, WOFF, SSP) { pg8::MultiOrder<1> S; S.s[0] = {(const bf16_t*)(ws + (AOFF)), (const bf16_t*)(ws + (WOFF)), 64, 44}; S.G = G; S.c = c; S.lda = DM; S.ldb = DM; \
        LAS float* tab = (LAS float*)(lds + pg8::STAGE_BYTES); \
        for (int e_ = tid_; e_ < 11 * 256; e_ += 512) { pg8::Unit u_; if (S.next(e_ >> 8, u_)) tab[e_] = rstd_of((SSP)[u_.pm * 256 + (e_ & 255)]); } __syncthreads(); \
        pg8::EpiSwiglu E{(bf16_t*)(ws + WS_ACT), tab}; pg8::gemm_phase(lds, DM, S, E); }
#define GEMM_RESID(MK, AOFF, WOFF, KK, ALPHA, SSP) { pg8::MultiOrder<1> S; S.s[0] = {(const bf16_t*)(ws + (AOFF)), (const bf16_t*)(ws + (WOFF)), 64, 8}; S.G = G; S.c = c; S.lda = (KK); S.ldb = (KK); \
        LAS float* tab = (LAS float*)(lds + pg8::STAGE_BYTES); \
        if (MK > 0) { const int rnd = tid_ >> 8, rl = tid_ & 255; pg8::Unit u_; if (S.next(rnd, u_)) { const int row = u_.pm * 256 + rl; \
            const float ra = rsqrtf(ss0[5 * MTOK + row] * (1.f / 1024) + EPS), rb = rsqrtf(ss0[6 * MTOK + row] * (1.f / 1024) + EPS); tab[rnd * 512 + rl] = ra / rb; tab[rnd * 512 + 256 + rl] = rb; } __syncthreads(); } \
        pg8::EpiResid<MK> E{(bf16_t*)(ws + WS_HB), (SSP), tab, (ALPHA)}; pg8::gemm_phase(lds, (KK), S, E); }
#define GEMM_FFN_OUT(WOFF, ALPHA, SSP) { pg8::MultiOrder<1, (size_t)MTOK * 128, (size_t)DM * 128> S; S.s[0] = {(const bf16_t*)(ws + WS_ACT), (const bf16_t*)(ws + (WOFF)), 64, 8}; S.G = G; S.c = c; S.lda = 64; S.ldb = 64; \
        pg8::EpiResid<0> E{(bf16_t*)(ws + WS_HB), (SSP), (LAS float*)(lds + pg8::STAGE_BYTES), (ALPHA)}; pg8::gemm_phase(lds, DFF, S, E); }
    float* const ss0 = (float*)(ws + WS_SS); float* const ss1 = ss0 + MTOK; float* const ss2 = ss1 + MTOK; float* const ss3 = ss2 + MTOK; float* const ss4 = ss3 + MTOK;
    PH_BEGIN(0) phase_prologue(p, lds, gw, ngw, wave, lane); PH_END(0)
#ifdef PROBE_DUP0
    PH_BEGIN(0) phase_prologue(p, lds, gw, ngw, wave, lane); PH_END(0)
#endif
    PH_BEGIN(1) GEMM_SWIGLU(WS_HB, WS_WT_IN1, ss0) PH_END(1)
    PH_BEGIN(2) GEMM_FFN_OUT(WS_WT_OUT1, 0.5f, ss1) PH_END(2)
    PH_BEGIN(3) {
        pg8::MultiOrder<2> S; const bf16_t* hn = (const bf16_t*)(ws + WS_HB); const bf16_t* wm = (const bf16_t*)(ws + WS_WT_MIXIN);
        S.s[0] = {hn, wm, 64, 16}; S.s[1] = {wm + (size_t)4096 * DM, hn, 4, 64};
        S.G = G; S.c = c; S.lda = DM; S.ldb = DM;
        LAS float* tab = (LAS float*)(lds + pg8::STAGE_BYTES);
        for (int e_ = tid_; e_ < 5 * 256; e_ += 512) { pg8::Unit u_; if (S.next(e_ >> 8, u_)) tab[e_] = rstd_of(ss1[(u_.sub == 0 ? u_.pm : u_.pn) * 256 + (e_ & 255)]); }
        __syncthreads();
        pg8::EpiMixIn E{ws, tab};
        pg8::gemm_phase(lds, DM, S, E); } PH_END(3)
    PH_BEGIN(4) {
        phase_stick_mfma(p, lds, wave, lane); __syncthreads();
        const int ng = G >> 1;
        if (c < ng) {
            pg8::MultiOrder<4> S; const bf16_t* mn = (const bf16_t*)(ws + WS_MEMN); const bf16_t* wkv = (const bf16_t*)(ws + WS_WT_CKV);
            S.s[0] = {mn, wkv, 0, 8}; S.s[1] = {mn, wkv, 0, 8}; S.s[2] = {mn, wkv, 8, 16}; S.s[3] = {mn, wkv, 0, 8};
            S.G = ng; S.c = c; S.lda = DM; S.ldb = DM;
            pg8::EpiMixIn E{ws, (LAS float*)(lds + pg8::STAGE_BYTES)};
            pg8::gemm_phase(lds, DM, S, E);
        } else phase_sgu_mfma(p, lds, wave, lane, c - ng, G - ng); } PH_END(4)
    PH_BEGIN(5) GEMM_RESID(16, WS_XN, WS_WT_MIXOUT, DM, 1.f, ss2) PH_END(5)
    PH_BEGIN(6) {
        pg8::CrossPrepOrder S{(const bf16_t*)(ws + WS_KV), (const bf16_t*)(ws + WS_VTX), (const bf16_t*)(ws + WS_WT_CQ), (const bf16_t*)(ws + WS_WT_CO), G, c, (size_t)DM, (size_t)DM};
        pg8::EpiCrossPrep E{(bf16_t*)(ws + WS_MT), (bf16_t*)(ws + WS_VWT)};
        pg8::gemm_phase(lds, 512, S, E); } PH_END(6)
    PH_BEGIN(7) {
        pg8::CrossSOrder S{(const bf16_t*)(ws + WS_HB), (const bf16_t*)(ws + WS_MT), G, c, (size_t)DM, (size_t)DM};
        LAS float* rtab = (LAS float*)(lds + pg8::STAGE_BYTES + 8192);
        { const int rnd = tid_ >> 8; pg8::Unit u_; if (S.next(rnd, u_)) rtab[tid_] = rstd_of(ss2[u_.pm * 256 + (tid_ & 255)]); }
        __syncthreads();
        pg8::EpiSoftmax E{(bf16_t*)(ws + WS_P), (LAS float*)(lds + pg8::STAGE_BYTES), rtab, 0.04419417382415922f * 1.4426950408889634f};
        pg8::gemm_phase(lds, DM, S, E); } PH_END(7)
    PH_BEGIN(8) {
        pg8::CrossOutOrder S{(const bf16_t*)(ws + WS_P), (const bf16_t*)(ws + WS_VWT), G, c, (size_t)1024, (size_t)1024};
        pg8::EpiResid<0> E{(bf16_t*)(ws + WS_HB), ss3, (LAS float*)(lds + pg8::STAGE_BYTES), 1.f};
        pg8::gemm_phase(lds, 1024, S, E); } PH_END(8)
    PH_BEGIN(9) GEMM_SWIGLU(WS_HB, WS_WT_IN2, ss3) PH_END(9)
    PH_BEGIN(10) GEMM_FFN_OUT(WS_WT_OUT2, 0.5f, ss4) PH_END(10)
    PH_BEGIN(11) phase_final_norm(p, gw, ngw, lane); PH_END(11)
}

extern "C" void kernel_launch(void* const* d_in, const int* in_sizes, int n_in, void* d_out, int out_size, void* d_ws, size_t ws_size, hipStream_t stream) {
    static int grid = 0;
    if (grid == 0) {
        if (n_in != 23 || out_size != MTOK * DM || ws_size < WS_END) { fprintf(stderr, "kernel_launch: unexpected problem (n_in %d out %d ws %zu, need %zu)\n", n_in, out_size, ws_size, (size_t)WS_END); grid = -1; return; }
        int dev = 0, cus = 0, per_cu = 0;
        hipGetDevice(&dev); hipDeviceGetAttribute(&cus, hipDeviceAttributeMultiprocessorCount, dev);
        if (hipFuncSetAttribute((const void*)mega, hipFuncAttributeMaxDynamicSharedMemorySize, LDS_BYTES) != hipSuccess) { fprintf(stderr, "kernel_launch: hipFuncSetAttribute failed\n"); grid = -1; return; }
        if (hipOccupancyMaxActiveBlocksPerMultiprocessor(&per_cu, (const void*)mega, 512, LDS_BYTES) != hipSuccess || per_cu < 1) { fprintf(stderr, "kernel_launch: occupancy query says %d\n", per_cu); per_cu = 1; }
        (void)hipGetLastError();
        grid = cus * per_cu;
    }
    if (grid < 0) return;
    Params p{};
    const float** pp = (const float**)&p;
    for (int i = 0; i < 23; ++i) pp[i] = (const float*)d_in[i];
    p.out = (float*)d_out; p.ws = (unsigned char*)d_ws; p.ph_lo = 0; p.ph_hi = NPHASES;
    if (hipMemsetAsync((unsigned char*)d_ws + WS_BAR, 0, 3456 * 4, stream) != hipSuccess) { fprintf(stderr, "kernel_launch: memset of the barrier words failed\n"); return; }
    void* args[] = {&p};
    hipError_t e = hipLaunchCooperativeKernel((const void*)mega, dim3(grid), dim3(512), args, LDS_BYTES, stream);
    if (e != hipSuccess) fprintf(stderr, "kernel_launch: cooperative launch failed: %s (grid %d)\n", hipGetErrorString(e), grid);
}
```
